# Optimizing an MI355X kernel written in HIP

```python
import math
import jax, jax.numpy as jnp
from jax import lax
import numpy as np

D_MODEL = 2048
BATCH = 4
SEQ = 2048
DEPTH = 2
DEC_BATCH = 8
DEC_SEQ = 4
PAST_LEN = 16384
PAGE_SIZE = 128

N_META = 16
N_EVEN = (DEPTH + 1) // 2
N_ODD = DEPTH // 2
D_ATT = D_MODEL // 2
N_DH = 8
DK = D_ATT // N_DH // 2
DV = 2 * DK
D_CONV = D_MODEL - D_ATT
CONV_W = 31
Q_BLOCK = 128
D_SSM = D_MODEL
SSM_GROUP = 16
N_SSM_GROUPS = D_SSM // SSM_GROUP
SSM_P = 64
D_FF = ((8 * D_MODEL // 3 + 255) // 256) * 256
EPS = 1e-6

kernel_name = 'hybrid_diffattn_conformer_s5_step'


def rms_norm(x, g):
    xf = x.astype(jnp.float32)
    y = xf * lax.rsqrt(jnp.mean(xf * xf, axis=-1, keepdims=True) + EPS)
    return (y * g.astype(jnp.float32)).astype(x.dtype)


def layer_norm(x, g, b):
    xf = x.astype(jnp.float32)
    mu = jnp.mean(xf, axis=-1, keepdims=True)
    var = jnp.mean(jnp.square(xf - mu), axis=-1, keepdims=True)
    y = (xf - mu) * lax.rsqrt(var + EPS)
    return (y * g.astype(jnp.float32) + b.astype(jnp.float32)).astype(x.dtype)


def alibi_slopes(n):
    return jnp.array([2.0 ** (-8.0 * (i + 1) / n) for i in range(n)], dtype=jnp.float32)


def diff_attn_core(q, qpos, segs, lam):
    slopes = alibi_slopes(N_DH)
    qf = q.astype(jnp.float32) * (DK ** -0.5)
    scores = []
    for k, v, kpos in segs:
        s = jnp.einsum('bqhmd,bshmd->bhmqs', qf, k.astype(jnp.float32))
        dist = (qpos[:, None] - kpos[None, :]).astype(jnp.float32)
        s = s - slopes[None, :, None, None, None] * jnp.abs(dist)
        scores.append(jnp.where(dist >= 0, s, -jnp.inf))
    p = jax.nn.softmax(jnp.concatenate(scores, axis=-1), axis=-1)
    out = 0.0
    off = 0
    for k, v, kpos in segs:
        n = kpos.shape[0]
        out = out + jnp.einsum('bhmqs,bshe->bqhme', p[..., off:off + n], v.astype(jnp.float32))
        off += n
    return out[:, :, :, 0] - lam * out[:, :, :, 1]


def prompt_diff_attention(q, k, v, lam):
    B, T = q.shape[0], q.shape[1]
    n_blk = -(-T // Q_BLOCK)
    t_pad = n_blk * Q_BLOCK
    qb = jnp.pad(q, ((0, 0), (0, t_pad - T), (0, 0), (0, 0), (0, 0)))
    qb = qb.reshape(B, n_blk, Q_BLOCK, N_DH, 2, DK).swapaxes(0, 1)
    kpos = jnp.arange(T, dtype=jnp.int32)

    def one(args):
        q_blk, start = args
        qpos = start + jnp.arange(Q_BLOCK, dtype=jnp.int32)
        return diff_attn_core(q_blk, qpos, [(k, v, kpos)], lam)

    o = lax.map(one, (qb, jnp.arange(n_blk, dtype=jnp.int32) * Q_BLOCK))
    return o.swapaxes(0, 1).reshape(B, t_pad, N_DH, DV)[:, :T]


def causal_dwconv(g_ext, w, b):
    out = lax.conv_general_dilated(g_ext, w.astype(g_ext.dtype)[:, None, :], window_strides=(1,),
                                   padding='VALID', dimension_numbers=('NWC', 'WIO', 'NWC'),
                                   feature_group_count=g_ext.shape[-1])
    return out + b.astype(g_ext.dtype)


def even_mixer(h, e, prm, past, conv_prev):
    B, T, _ = h.shape
    proj = h @ prm['w_in_even'][e]
    q, k, v, cv, cg = jnp.split(proj, [D_ATT, 2 * D_ATT, 3 * D_ATT, 3 * D_ATT + D_CONV], axis=-1)
    q = q.reshape(B, T, N_DH, 2, DK)
    k = k.reshape(B, T, N_DH, 2, DK)
    v = v.reshape(B, T, N_DH, DV)
    lam_init = 0.8 - 0.6 * math.exp(-0.3 * (2 * e))
    lq = prm['lambda_q'][e].astype(jnp.float32)
    lk = prm['lambda_k'][e].astype(jnp.float32)
    lam = jnp.exp(jnp.sum(lq[0] * lk[0])) - jnp.exp(jnp.sum(lq[1] * lk[1])) + lam_init
    if past is None:
        o = prompt_diff_attention(q, k, v, lam)
    else:
        cache_k, cache_v, page_table = past
        past_len = page_table.shape[1] * PAGE_SIZE
        k_past = cache_k[e, page_table].reshape(B, past_len, N_DH, 2, DK)
        v_past = cache_v[e, page_table].reshape(B, past_len, N_DH, DV)
        qpos = past_len + jnp.arange(T, dtype=jnp.int32)
        o = diff_attn_core(q, qpos, [(k_past, v_past, jnp.arange(past_len, dtype=jnp.int32)), (k, v, qpos)], lam)
    o = (rms_norm(o, prm['subln_g'][e]) * (1.0 - lam_init)).reshape(B, T, D_ATT).astype(h.dtype)
    g = cv * jax.nn.sigmoid(cg)
    if conv_prev is None:
        conv_prev = jnp.zeros((B, CONV_W - 1, D_CONV), g.dtype)
    g_ext = jnp.concatenate([conv_prev.astype(g.dtype), g], axis=1)
    c = causal_dwconv(g_ext, prm['conv_w'][e], prm['conv_b'][e])
    c = jax.nn.silu(layer_norm(c, prm['conv_ln_g'][e], prm['conv_ln_b'][e]))
    y = jnp.concatenate([o, c], axis=-1) @ prm['w_out_even'][e]
    return y, k, v, g_ext[:, -(CONV_W - 1):]


def odd_mixer(h, o, prm, h0_re, h0_im):
    B, T, _ = h.shape
    f32 = jnp.float32
    u = (h @ prm['w_in_odd'][o]).reshape(B, T, N_SSM_GROUPS, SSM_GROUP).astype(f32)
    lam_c = lax.complex(prm['ssm_a_re'][o].astype(f32), prm['ssm_a_im'][o].astype(f32))
    dt = jnp.exp(prm['ssm_log_dt'][o].astype(f32))[:, None]
    abar = jnp.exp(lam_c * dt)
    coef = (abar - 1.0) / lam_c
    b_re = prm['ssm_b_re'][o].astype(f32)
    b_im = prm['ssm_b_im'][o].astype(f32)
    bb_re = coef.real[..., None] * b_re - coef.imag[..., None] * b_im
    bb_im = coef.real[..., None] * b_im + coef.imag[..., None] * b_re
    bu = lax.complex(jnp.einsum('gpc,btgc->btgp', bb_re, u), jnp.einsum('gpc,btgc->btgp', bb_im, u))
    h0 = lax.complex(h0_re.astype(f32), h0_im.astype(f32))
    bu = bu.at[:, 0].add(abar * h0)
    a_seq = jnp.broadcast_to(abar, (1, T, N_SSM_GROUPS, SSM_P))

    def comb(l, r):
        a1, b1 = l
        a2, b2 = r
        return (a1 * a2, a2 * b1 + b2)

    _, states = lax.associative_scan(comb, (a_seq, bu), axis=1)
    y = (jnp.einsum('gcp,btgp->btgc', prm['ssm_c_re'][o].astype(f32), states.real)
         - jnp.einsum('gcp,btgp->btgc', prm['ssm_c_im'][o].astype(f32), states.imag)
         + prm['ssm_d'][o].astype(f32) * u)
    y = jax.nn.gelu(y.reshape(B, T, D_SSM)).astype(h.dtype)
    y = y * jax.nn.sigmoid(y @ prm['w_glu'][o])
    last = states[:, -1]
    return y @ prm['w_out_odd'][o], last.real, last.imag


def swiglu(h, wg, wu, wd):
    return (jax.nn.silu(h @ wg) * (h @ wu)) @ wd


def run_trunk(x, prm, past, conv_prev, ssm_prev_re, ssm_prev_im):
    B = x.shape[0]
    ks, vs, convs, sres, sims = [], [], [], [], []
    for l in range(DEPTH):
        h = rms_norm(x, prm['norm_mix_pre'][l])
        if l % 2 == 0:
            e = l // 2
            cp = None if conv_prev is None else conv_prev[e]
            m, k, v, c = even_mixer(h, e, prm, past, cp)
            ks.append(k)
            vs.append(v)
            convs.append(c)
        else:
            o = l // 2
            if ssm_prev_re is None:
                h0r = jnp.zeros((B, N_SSM_GROUPS, SSM_P), jnp.float32)
                h0i = h0r
            else:
                h0r, h0i = ssm_prev_re[o], ssm_prev_im[o]
            m, sr, si = odd_mixer(h, o, prm, h0r, h0i)
            sres.append(sr.astype(x.dtype))
            sims.append(si.astype(x.dtype))
        x = x + rms_norm(m, prm['norm_mix_post'][l])
        h = rms_norm(x, prm['norm_ffn_pre'][l])
        f = swiglu(h, prm['w_ffn_gate'][l], prm['w_ffn_up'][l], prm['w_ffn_down'][l])
        x = x + rms_norm(f, prm['norm_ffn_post'][l])
    return x, jnp.stack(ks), jnp.stack(vs), jnp.stack(convs), jnp.stack(sres), jnp.stack(sims)


def setup_inputs(seed: int = 0) -> dict:
    key = jax.random.key(seed)
    keys = iter(jax.random.split(key, 48))
    f32 = jnp.float32

    def nrm(shape, scale):
        return jax.random.normal(next(keys), shape, f32) * scale

    n_pages = PAST_LEN // PAGE_SIZE
    n_used = DEC_BATCH * n_pages
    n_pool = (5 * n_used + 3) // 4
    G, P = N_SSM_GROUPS, SSM_P
    inp = {}
    inp['x_prompt'] = nrm((BATCH, SEQ, D_MODEL), 1.0)
    inp['x_sample'] = nrm((DEC_BATCH, DEC_SEQ, D_MODEL), 1.0)
    inp['cache_k'] = nrm((N_EVEN, n_pool, PAGE_SIZE, N_DH, 2, DK), 1.0)
    inp['cache_v'] = nrm((N_EVEN, n_pool, PAGE_SIZE, N_DH, DV), 1.0)
    inp['state_conv'] = nrm((N_EVEN, DEC_BATCH, CONV_W - 1, D_CONV), 0.5)
    inp['state_ssm_re'] = nrm((N_ODD, DEC_BATCH, G, P), 0.1)
    inp['state_ssm_im'] = nrm((N_ODD, DEC_BATCH, G, P), 0.1)
    perm = jax.random.permutation(next(keys), n_pool)[:n_used]
    inp['page_table'] = perm.reshape(DEC_BATCH, n_pages).astype(jnp.int32)
    inp['meta_tokens'] = nrm((N_META, D_MODEL), 1.0)
    inp['norm_mix_pre'] = 1.0 + nrm((DEPTH, D_MODEL), 0.02)
    inp['norm_mix_post'] = 1.0 + nrm((DEPTH, D_MODEL), 0.02)
    inp['norm_ffn_pre'] = 1.0 + nrm((DEPTH, D_MODEL), 0.02)
    inp['norm_ffn_post'] = 1.0 + nrm((DEPTH, D_MODEL), 0.02)
    inp['w_in_even'] = nrm((N_EVEN, D_MODEL, 3 * D_ATT + 2 * D_CONV), D_MODEL ** -0.5)
    inp['lambda_q'] = nrm((N_EVEN, 2, DK), 0.1)
    inp['lambda_k'] = nrm((N_EVEN, 2, DK), 0.1)
    inp['subln_g'] = 1.0 + nrm((N_EVEN, DV), 0.02)
    inp['conv_w'] = nrm((N_EVEN, CONV_W, D_CONV), CONV_W ** -0.5)
    inp['conv_b'] = nrm((N_EVEN, D_CONV), 0.01)
    inp['conv_ln_g'] = 1.0 + nrm((N_EVEN, D_CONV), 0.02)
    inp['conv_ln_b'] = nrm((N_EVEN, D_CONV), 0.01)
    inp['w_out_even'] = nrm((N_EVEN, D_ATT + D_CONV, D_MODEL), (D_ATT + D_CONV) ** -0.5)
    inp['w_in_odd'] = nrm((N_ODD, D_MODEL, D_SSM), D_MODEL ** -0.5)
    inp['ssm_a_re'] = -0.5 * jnp.exp(nrm((N_ODD, G, P), 0.1))
    inp['ssm_a_im'] = math.pi * jnp.arange(P, dtype=f32)[None, None, :] + nrm((N_ODD, G, P), 0.01)
    inp['ssm_b_re'] = nrm((N_ODD, G, P, SSM_GROUP), (2.0 * SSM_GROUP) ** -0.5)
    inp['ssm_b_im'] = nrm((N_ODD, G, P, SSM_GROUP), (2.0 * SSM_GROUP) ** -0.5)
    inp['ssm_c_re'] = nrm((N_ODD, G, SSM_GROUP, P), (2.0 * P) ** -0.5)
    inp['ssm_c_im'] = nrm((N_ODD, G, SSM_GROUP, P), (2.0 * P) ** -0.5)
    inp['ssm_d'] = nrm((N_ODD, G, SSM_GROUP), 1.0)
    inp['ssm_log_dt'] = jax.random.uniform(next(keys), (N_ODD, G), f32, math.log(1e-3), math.log(1e-1))
    inp['w_glu'] = nrm((N_ODD, D_SSM, D_SSM), D_SSM ** -0.5)
    inp['w_out_odd'] = nrm((N_ODD, D_SSM, D_MODEL), D_SSM ** -0.5)
    inp['w_ffn_gate'] = nrm((DEPTH, D_MODEL, D_FF), D_MODEL ** -0.5)
    inp['w_ffn_up'] = nrm((DEPTH, D_MODEL, D_FF), D_MODEL ** -0.5)
    inp['w_ffn_down'] = nrm((DEPTH, D_FF, D_MODEL), D_FF ** -0.5)
    return inp


def reference(x_prompt, x_sample, cache_k, cache_v, state_conv, state_ssm_re, state_ssm_im, page_table,
              meta_tokens, norm_mix_pre, norm_mix_post, norm_ffn_pre, norm_ffn_post,
              w_in_even, lambda_q, lambda_k, subln_g, conv_w, conv_b, conv_ln_g, conv_ln_b, w_out_even,
              w_in_odd, ssm_a_re, ssm_a_im, ssm_b_re, ssm_b_im, ssm_c_re, ssm_c_im, ssm_d, ssm_log_dt,
              w_glu, w_out_odd, w_ffn_gate, w_ffn_up, w_ffn_down):
    prm = dict(norm_mix_pre=norm_mix_pre, norm_mix_post=norm_mix_post, norm_ffn_pre=norm_ffn_pre,
               norm_ffn_post=norm_ffn_post, w_in_even=w_in_even, lambda_q=lambda_q, lambda_k=lambda_k,
               subln_g=subln_g, conv_w=conv_w, conv_b=conv_b, conv_ln_g=conv_ln_g, conv_ln_b=conv_ln_b,
               w_out_even=w_out_even, w_in_odd=w_in_odd, ssm_a_re=ssm_a_re, ssm_a_im=ssm_a_im,
               ssm_b_re=ssm_b_re, ssm_b_im=ssm_b_im, ssm_c_re=ssm_c_re, ssm_c_im=ssm_c_im, ssm_d=ssm_d,
               ssm_log_dt=ssm_log_dt, w_glu=w_glu, w_out_odd=w_out_odd, w_ffn_gate=w_ffn_gate,
               w_ffn_up=w_ffn_up, w_ffn_down=w_ffn_down)
    B = x_prompt.shape[0]
    meta = jnp.broadcast_to(meta_tokens.astype(x_prompt.dtype)[None], (B, N_META, x_prompt.shape[-1]))
    xp = jnp.concatenate([meta, x_prompt], axis=1)
    yp, k_prompt, v_prompt, conv_prompt, ssm_re_prompt, ssm_im_prompt = run_trunk(xp, prm, None, None, None, None)
    y_prompt = yp[:, N_META:]
    y_sample, k_sample, v_sample, conv_sample, ssm_re_sample, ssm_im_sample = run_trunk(
        x_sample, prm, (cache_k, cache_v, page_table), state_conv, state_ssm_re, state_ssm_im)
    return (y_prompt, y_sample, k_prompt, v_prompt, k_sample, v_sample, conv_prompt, conv_sample,
            ssm_re_prompt, ssm_im_prompt, ssm_re_sample, ssm_im_sample)
```

```cpp
#ifndef HOST_EMU
#include <hip/hip_runtime.h>
#include <cstdio>
#include <cstdint>
#include <cmath>
#define LAS __attribute__((address_space(3)))
#define GAS __attribute__((address_space(1)))
typedef short bf16x8 __attribute__((ext_vector_type(8)));
typedef float f32x4 __attribute__((ext_vector_type(4)));
typedef float f32x2 __attribute__((ext_vector_type(2)));
typedef float f32x16 __attribute__((ext_vector_type(16)));
typedef unsigned u32x4 __attribute__((ext_vector_type(4)));
typedef unsigned u32x2 __attribute__((ext_vector_type(2)));
__device__ __forceinline__ float px_shfl_xor(float v, int m) { return __shfl_xor(v, m); }
__device__ __forceinline__ float px_shfl(float v, int src) { return __shfl(v, src); }
__device__ __forceinline__ int px_shfl_i(int v, int src) { return __shfl(v, src); }
__device__ __forceinline__ int px_readlane(int v, int src) { return __builtin_amdgcn_readlane(v, src); }
__device__ __forceinline__ int px_rfl(int v) { return __builtin_amdgcn_readfirstlane(v); }
__device__ __forceinline__ void px_wave_sync() { asm volatile("s_waitcnt lgkmcnt(0)" ::: "memory"); __builtin_amdgcn_wave_barrier(); }
__device__ __forceinline__ void px_block_sync() { __syncthreads(); }
__device__ __forceinline__ float px_exp2(float x) { return __builtin_amdgcn_exp2f(x); }
__device__ __forceinline__ float px_rcp(float x) { return __builtin_amdgcn_rcpf(x); }
__device__ __forceinline__ float px_rsq(float x) { return 1.0f / sqrtf(x); }
__device__ __forceinline__ void px_swap32(float a, float b, float& r0, float& r1) {
    auto rr = __builtin_amdgcn_permlane32_swap(__float_as_uint(a), __float_as_uint(b), false, false); r0 = __uint_as_float(rr[0]); r1 = __uint_as_float(rr[1]); }
__device__ __forceinline__ void px_swap16(float a, float b, float& r0, float& r1) {
    auto rr = __builtin_amdgcn_permlane16_swap(__float_as_uint(a), __float_as_uint(b), false, false); r0 = __uint_as_float(rr[0]); r1 = __uint_as_float(rr[1]); }
template <int CTRL> __device__ __forceinline__ float px_dpp(float x) { return __builtin_bit_cast(float, __builtin_amdgcn_mov_dpp(__builtin_bit_cast(int, x), CTRL, 0xf, 0xf, true)); }
__device__ __forceinline__ f32x4 px_mfma16(bf16x8 a, bf16x8 b, f32x4 c) { return __builtin_amdgcn_mfma_f32_16x16x32_bf16(a, b, c, 0, 0, 0); }
__device__ __forceinline__ f32x16 px_mfma32(bf16x8 a, bf16x8 b, f32x16 c) { return __builtin_amdgcn_mfma_f32_32x32x16_bf16(a, b, c, 0, 0, 0); }
typedef __bf16 px_bf16x2 __attribute__((ext_vector_type(2)));
__device__ __forceinline__ float px_dot2(unsigned k, unsigned q, float acc) { return __builtin_amdgcn_fdot2_f32_bf16(__builtin_bit_cast(px_bf16x2, k), __builtin_bit_cast(px_bf16x2, q), acc, false); }
template <class T> __device__ __forceinline__ T px_ntload(const T* p) { return __builtin_nontemporal_load(p); }
__device__ __forceinline__ u32x4 px_bufload16(const void* ubase, unsigned voff) {
    const __amdgpu_buffer_rsrc_t rs = __builtin_amdgcn_make_buffer_rsrc((void*)ubase, (short)0, 0x20000000, 0x00020000);
    return __builtin_amdgcn_raw_buffer_load_b128(rs, voff, 0, 2); }
#define PX_DYN_LDS(name) extern __shared__ __attribute__((aligned(16))) unsigned char name[]
__device__ __forceinline__ unsigned px_atomic_add(unsigned* p, unsigned v) { return __hip_atomic_fetch_add(p, v, __ATOMIC_RELAXED, __HIP_MEMORY_SCOPE_AGENT); }
__device__ __forceinline__ unsigned px_cvtpk(float lo, float hi) { f32x2 v = {lo, hi}; px_bf16x2 b = __builtin_convertvector(v, px_bf16x2); return __builtin_bit_cast(unsigned, b); }
#define EMU_UNIT_OK(u) true
#define PX_OPAQUE_S(x) asm volatile("" : "+s"(x))
#define PX_OPAQUE_V(x) asm volatile("" : "+v"(x))
__device__ __forceinline__ int px_lane_id() { int l; asm volatile("v_mbcnt_lo_u32_b32 %0, -1, 0\n\tv_mbcnt_hi_u32_b32 %0, -1, %0" : "=v"(l)); return l; }
#else
#define PX_OPAQUE_S(x) asm volatile("" : "+r"(x))
#define PX_OPAQUE_V(x) asm volatile("" : "+r"(x))
static inline u32x4 px_bufload16(const void* ubase, unsigned voff) { return *(const u32x4*)((const char*)ubase + voff); }
static inline int px_lane_id() { return g_cur->tid & 63; }
static inline unsigned px_cvtpk(float lo, float hi);
#define EMU_UNIT_OK(u) ((u) >= emu_unit_lo && (u) < emu_unit_hi)
#endif

typedef unsigned short bf16;
__device__ __forceinline__ unsigned f2bf(float f) { unsigned u = __builtin_bit_cast(unsigned, f); return (u + 0x7fffu + ((u >> 16) & 1u)) >> 16; }
__device__ __forceinline__ unsigned pk2(float lo, float hi) { return f2bf(lo) | (f2bf(hi) << 16); }
#ifdef HOST_EMU
static inline unsigned px_cvtpk(float lo, float hi) { return pk2(lo, hi); }
#endif
__device__ __forceinline__ float bf_lo(unsigned w) { return __builtin_bit_cast(float, w << 16); }
__device__ __forceinline__ float bf_hi(unsigned w) { return __builtin_bit_cast(float, w & 0xffff0000u); }
__device__ __forceinline__ float bf2f(bf16 b) { return __builtin_bit_cast(float, (unsigned)b << 16); }
__device__ __forceinline__ float sigmoidf_(float x) { return px_rcp(1.0f + px_exp2(-1.4426950408889634f * x)); }
__device__ __forceinline__ float siluf_(float x) { return x * sigmoidf_(x); }
__device__ __forceinline__ float gelu_tanh(float x) {
    const float u = 1.5957691216057308f * (x + 0.044715f * x * x * x); return x * sigmoidf_(u); }
__device__ __forceinline__ float wave_sum(float v) {
#pragma unroll
    for (int o = 1; o < 64; o <<= 1) v += px_shfl_xor(v, o);
    return v; }
__device__ __forceinline__ float wave_max(float v) {
#pragma unroll
    for (int o = 1; o < 64; o <<= 1) v = fmaxf(v, px_shfl_xor(v, o));
    return v; }

constexpr int DM = 2048, NBATCH = 4, SEQ = 2048, TFULL = 2064, MAIN = 8192, META0 = 8192, NMETA = 16, SMP0 = 8208, NSMP = 32, NREAL = 8240, MP = 8448;
constexpr int DFF = 5632, NGU = 2 * DFF, NIN0 = 5120, TPREF = 128, KROWS = TPREF + SEQ;
constexpr int NPAGE = 128, PAGE_TOK = 128, PASTLEN = 16384;
constexpr float EPSN = 1e-6f;
constexpr float QSCALE = 0.125f * 1.4426950408889634f;
constexpr size_t OFF_YP = 0, OFF_YS = OFF_YP + (size_t)NBATCH * SEQ * DM, OFF_KP = OFF_YS + (size_t)NSMP * DM, OFF_VP = OFF_KP + (size_t)NBATCH * TFULL * 1024,
                 OFF_KS = OFF_VP + (size_t)NBATCH * TFULL * 1024, OFF_VS = OFF_KS + (size_t)NSMP * 1024, OFF_CP = OFF_VS + (size_t)NSMP * 1024, OFF_CS = OFF_CP + (size_t)NBATCH * 30 * 1024,
                 OFF_SRP = OFF_CS + (size_t)8 * 30 * 1024, OFF_SIP = OFF_SRP + (size_t)NBATCH * 128 * 64, OFF_SRS = OFF_SIP + (size_t)NBATCH * 128 * 64, OFF_SIS = OFF_SRS + (size_t)8 * 128 * 64,
                 OUT_TOTAL = OFF_SIS + (size_t)8 * 128 * 64;
enum { I_XP = 0, I_XS, I_CK, I_CV, I_SCONV, I_SSRE, I_SSIM, I_PT, I_META, I_NMPRE, I_NMPOST, I_NFPRE, I_NFPOST, I_WIN0, I_LQ, I_LK, I_SUBG, I_CW, I_CB, I_CLG, I_CLB, I_WOUT0,
       I_WIN1, I_ARE, I_AIM, I_BRE, I_BIM, I_CRE, I_CIM, I_SD, I_LDT, I_WGLU, I_WOUT1, I_WG, I_WU, I_WD, N_IN };
constexpr size_t MiB = 1u << 20;
constexpr size_t WS_CTL = 0, CTL_ZERO_BYTES = 1 * MiB;
constexpr size_t WS_PAR = 1 * MiB;
constexpr size_t PAR_LAM = 0, PAR_ABAR = 4096, PAR_PW = 131072, PAR_BBT = 1 * MiB, PAR_CCT = 2 * MiB;
constexpr size_t WS_WIN0 = 16 * MiB, WS_WOUT0 = 36 * MiB, WS_WGU0 = 44 * MiB, WS_WD0 = 88 * MiB, WS_WIN1 = 110 * MiB, WS_WGLU = 118 * MiB, WS_WOUT1 = 126 * MiB, WS_WGU1 = 134 * MiB, WS_WD1 = 178 * MiB;
constexpr size_t WS_XB = 200 * MiB, WS_RS = 234 * MiB, WS_XX = 235 * MiB, WS_Q = 238 * MiB, WS_KB = 256 * MiB, WS_VB = 274 * MiB, WS_G = 292 * MiB, WS_O2 = 310 * MiB, WS_OC = 342 * MiB;
constexpr size_t WS_M = 376 * MiB, WS_HID = 442 * MiB, WS_U = 534 * MiB, WS_Y = 568 * MiB, WS_Y2 = 602 * MiB, WS_SSME = 636 * MiB, WS_DEC = 640 * MiB, WS_END = 672 * MiB;
constexpr int NSD = 4;
constexpr int DEC_REC = 132;
constexpr int CW_TMO = 0, CW_CODE = 1, CW_BAR = 4096;

namespace pg8 {
#ifndef HOST_EMU
#define PG8_LAS __attribute__((address_space(3)))
#else
#define PG8_LAS
#endif
typedef unsigned short bf16_t;
typedef short bf16x8 __attribute__((ext_vector_type(8)));
typedef float f32x4 __attribute__((ext_vector_type(4)));
typedef unsigned u32x4 __attribute__((ext_vector_type(4)));
constexpr int BM = 256, BK = 64, HALF = 128, HTB = HALF * BK * 2  , STAGE_BYTES = 8 * HTB, NXCD = 8, WGM = 8;

__host__ __device__ __forceinline__ int lds_byte(int r, int c) { const int st = (r >> 4) * 2 + (c >> 5), rr = r & 15, cc = c & 31, ob = rr * 64 + cc * 2; return st * 1024 + (ob ^ (((ob >> 9) & 1) << 5)); }
__host__ __device__ __forceinline__ void stage_rc(int b, int& R, int& C) { const int st = b / 1024, sb = b % 1024, swz = sb ^ (((sb >> 9) & 1) << 5); R = (st >> 1) * 16 + swz / 64; C = (st & 1) * 32 + (swz % 64) / 2; }
__host__ __device__ __forceinline__ int perm32(int rho) { const int n = rho >> 4, i = rho & 15; return 8 * (i >> 2) + 4 * n + (i & 3); }

struct Unit { int pm, pn; };
struct Gemm { const bf16_t* A; const bf16_t* Bt; int M, N, K; };

struct StaticOrder {
    int nM, nN, nwg, G, c;
    __host__ __device__ void init(int M, int N, int G_, int c_) { nM = M / BM; nN = N / BM; nwg = nM * nN; G = G_; c = c_; }
    __host__ __device__ bool next(int i, Unit& u) const {
        const long L = (long)i * G + c; if (L >= nwg) return false;
        int wgid = (int)L; { const int q = nwg / NXCD, r = nwg % NXCD, xcd = wgid % NXCD, off = wgid / NXCD; wgid = (xcd < r ? xcd * (q + 1) : r * (q + 1) + (xcd - r) * q) + off; }
        const int nig = WGM * nN, gid = wgid / nig, fm = gid * WGM, gsz = (nM - fm) < WGM ? (nM - fm) : WGM;
        u.pm = fm + ((wgid % nig) % gsz); u.pn = (wgid % nig) / gsz; return true;
    }
    __device__ __forceinline__ void a_ready(const Unit&) const {}
    __device__ __forceinline__ void done(const Unit&) const {}
};

}
namespace pg8 {
#ifndef HOST_EMU
__device__ __forceinline__ unsigned cvtpk(float lo, float hi) { unsigned r; asm volatile("v_cvt_pk_bf16_f32 %0, %1, %2" : "=v"(r) : "v"(lo), "v"(hi)); return r; }
#else
inline unsigned cvtpk(float lo, float hi) { return pk2(lo, hi); }
#endif
__device__ __forceinline__ u32x4 pack8(f32x4 a, f32x4 b) { u32x4 w; w.x = cvtpk(a[0], a[1]); w.y = cvtpk(a[2], a[3]); w.z = cvtpk(b[0], b[1]); w.w = cvtpk(b[2], b[3]); return w; }
__device__ __forceinline__ f32x4 sig4(f32x4 x) { f32x4 r; r[0] = sigmoidf_(x[0]); r[1] = sigmoidf_(x[1]); r[2] = sigmoidf_(x[2]); r[3] = sigmoidf_(x[3]); return r; }

struct EpiIn0 {
    static constexpr bool PERM = true, AFTER_DRAIN = false;
    const float* rs; bf16* Qb; bf16* Kb; bf16* Vb; bf16* Gb; float* out;
    __device__ __forceinline__ void operator()(const f32x4 (&acc)[2][2][4][2], const Unit& u, int wr, int wc, int fr, int fq) const {
        const int pn = u.pn, cl = wc * 32 + 8 * fq;
#pragma unroll
        for (int ai = 0; ai < 2; ++ai)
#pragma unroll
            for (int m = 0; m < 4; ++m) {
                const int row = u.pm * BM + ai * HALF + wr * 64 + m * 16 + fr;
                if (row >= NREAL) continue;
                const float r = rs[row];
                if (pn < 12) {
#pragma unroll
                    for (int bj = 0; bj < 2; ++bj) {
                        f32x4 v0 = acc[ai][bj][m][0] * r, v1 = acc[ai][bj][m][1] * r;
                        const int col = 256 * (pn & 3) + 128 * bj + cl;
                        if (pn < 4) { v0 = v0 * QSCALE; v1 = v1 * QSCALE; *(u32x4*)(Qb + (size_t)row * 1024 + col) = pack8(v0, v1); }
                        else {
                            bf16* B = pn < 8 ? Kb : Vb; const u32x4 w = pack8(v0, v1);
                            if (row < MAIN) { const int b = row >> 11, s = row & 2047;
                                *(u32x4*)(B + ((size_t)(b * KROWS + TPREF + s) * 1024 + col)) = w;
                                float* o = out + (pn < 8 ? OFF_KP : OFF_VP) + ((size_t)(b * TFULL + NMETA + s) * 1024 + col); *(f32x4*)o = v0; *(f32x4*)(o + 4) = v1; }
                            else if (row < SMP0) { const int j = row - META0;
#pragma unroll
                                for (int bb = 0; bb < NBATCH; ++bb) { *(u32x4*)(B + ((size_t)(bb * KROWS + j) * 1024 + col)) = w;
                                    float* o = out + (pn < 8 ? OFF_KP : OFF_VP) + ((size_t)(bb * TFULL + j) * 1024 + col); *(f32x4*)o = v0; *(f32x4*)(o + 4) = v1; } }
                            else { const int i = row - SMP0; float* o = out + (pn < 8 ? OFF_KS : OFF_VS) + ((size_t)i * 1024 + col); *(f32x4*)o = v0; *(f32x4*)(o + 4) = v1; }
                        }
                    }
                } else {
                    const int ch = 128 * (pn - 12) + cl;
                    const f32x4 g0 = (acc[ai][0][m][0] * r) * sig4(acc[ai][1][m][0] * r), g1 = (acc[ai][0][m][1] * r) * sig4(acc[ai][1][m][1] * r);
                    *(u32x4*)(Gb + (size_t)row * 1024 + ch) = pack8(g0, g1);
                    if (row < MAIN) { const int s = row & 2047; if (s >= SEQ - 30) { const int b = row >> 11; float* o = out + OFF_CP + ((size_t)(b * 30 + (s - (SEQ - 30))) * 1024 + ch); *(f32x4*)o = g0; *(f32x4*)(o + 4) = g1; } }
                    else if (row >= SMP0) { const int i = row - SMP0; float* o = out + OFF_CS + ((size_t)((i >> 2) * 30 + 26 + (i & 3)) * 1024 + ch); *(f32x4*)o = g0; *(f32x4*)(o + 4) = g1; }
                }
            }
    }
};
struct EpiF32 {
    static constexpr bool PERM = false, AFTER_DRAIN = false;
    float* M; int ldc;
    __device__ __forceinline__ void operator()(const f32x4 (&acc)[2][2][4][2], const Unit& u, int wr, int wc, int fr, int fq) const {
        const int col0 = u.pn * BM + wc * 32 + 4 * fq;
#pragma unroll
        for (int ai = 0; ai < 2; ++ai)
#pragma unroll
            for (int m = 0; m < 4; ++m) { const int row = u.pm * BM + ai * HALF + wr * 64 + m * 16 + fr; if (row >= NREAL) continue;
                float* rp = M + (size_t)row * ldc + col0;
#pragma unroll
                for (int bj = 0; bj < 2; ++bj)
#pragma unroll
                    for (int n = 0; n < 2; ++n) *(f32x4*)(rp + bj * HALF + n * 16) = acc[ai][bj][m][n]; }
    }
};
struct EpiGU {
    static constexpr bool PERM = true, AFTER_DRAIN = false;
    const float* rs; bf16* H;
    __device__ __forceinline__ void operator()(const f32x4 (&acc)[2][2][4][2], const Unit& u, int wr, int wc, int fr, int fq) const {
        const int hc = 128 * u.pn + wc * 32 + 8 * fq;
#pragma unroll
        for (int ai = 0; ai < 2; ++ai)
#pragma unroll
            for (int m = 0; m < 4; ++m) { const int row = u.pm * BM + ai * HALF + wr * 64 + m * 16 + fr; const float r = rs[row];
                f32x4 h[2];
#pragma unroll
                for (int n = 0; n < 2; ++n) { const f32x4 g = acc[ai][0][m][n] * r, up = acc[ai][1][m][n] * r; h[n] = g * sig4(g) * up; }
                *(u32x4*)(H + (size_t)row * DFF + hc) = pack8(h[0], h[1]); }
    }
};
struct EpiU {
    static constexpr bool PERM = true, AFTER_DRAIN = false;
    const float* rs; bf16* U;
    __device__ __forceinline__ void operator()(const f32x4 (&acc)[2][2][4][2], const Unit& u, int wr, int wc, int fr, int fq) const {
#pragma unroll
        for (int ai = 0; ai < 2; ++ai)
#pragma unroll
            for (int m = 0; m < 4; ++m) { const int row = u.pm * BM + ai * HALF + wr * 64 + m * 16 + fr; const float r = rs[row];
#pragma unroll
                for (int bj = 0; bj < 2; ++bj) *(u32x4*)(U + (size_t)row * DM + u.pn * BM + bj * HALF + wc * 32 + 8 * fq) = pack8(acc[ai][bj][m][0] * r, acc[ai][bj][m][1] * r); }
    }
};
struct EpiGlu {
    static constexpr bool PERM = true, AFTER_DRAIN = false;
    const bf16* Y; bf16* Y2;
    __device__ __forceinline__ void operator()(const f32x4 (&acc)[2][2][4][2], const Unit& u, int wr, int wc, int fr, int fq) const {
#pragma unroll
        for (int ai = 0; ai < 2; ++ai)
#pragma unroll
            for (int m = 0; m < 4; ++m) { const int row = u.pm * BM + ai * HALF + wr * 64 + m * 16 + fr;
#pragma unroll
                for (int bj = 0; bj < 2; ++bj) { const size_t off = (size_t)row * DM + u.pn * BM + bj * HALF + wc * 32 + 8 * fq;
                    const u32x4 yv = *(const u32x4*)(Y + off);
                    const f32x4 y0 = {bf_lo(yv.x), bf_hi(yv.x), bf_lo(yv.y), bf_hi(yv.y)}, y1 = {bf_lo(yv.z), bf_hi(yv.z), bf_lo(yv.w), bf_hi(yv.w)};
                    *(u32x4*)(Y2 + off) = pack8(y0 * sig4(acc[ai][bj][m][0]), y1 * sig4(acc[ai][bj][m][1])); } }
    }
};
#ifdef HOST_EMU
template <class Epi, class Sched, bool ALIGN_EPI = false, bool SP2 = false>
inline void gemm_phase(unsigned char* lds, const Gemm g, const Sched& S, const Epi& E) {
    const int tid = threadIdx.x, wid = tid >> 6, lane = tid & 63, wr = wid >> 2, wc = wid & 3, fr = lane & 15, fq = lane >> 4;
    Unit cur;
    for (int ui = 0; S.next(ui, cur); ++ui) {
        const long L = (long)ui * S.G + S.c; if (!EMU_UNIT_OK(L)) continue;
        f32x4 acc[2][2][4][2];
        for (int ai = 0; ai < 2; ++ai) for (int bj = 0; bj < 2; ++bj) for (int m = 0; m < 4; ++m) for (int n = 0; n < 2; ++n) for (int i = 0; i < 4; ++i) {
            const int row = cur.pm * BM + ai * HALF + wr * 64 + m * 16 + fr;
            const int col = cur.pn * BM + bj * HALF + wc * 32 + (Epi::PERM ? 8 * fq + 4 * n + i : 16 * n + 4 * fq + i);
            const bf16_t* a = g.A + (size_t)row * g.K; const bf16_t* b = g.Bt + (size_t)col * g.K; double s = 0.0;
            for (int k = 0; k < g.K; ++k) s += (double)bf2f(a[k]) * (double)bf2f(b[k]);
            acc[ai][bj][m][n][i] = (float)s; }
        E(acc, cur, wr, wc, fr, fq);
    }
}
#endif
}
#ifndef HOST_EMU
namespace pg8 {
template <class Epi, class Sched, bool ALIGN_EPI = false, bool SP2 = false>
__device__ __forceinline__ void gemm_phase(PG8_LAS unsigned char* lds, const Gemm g, const Sched& S, const Epi& E) {
    const int tid = threadIdx.x, wid = __builtin_amdgcn_readfirstlane(tid >> 6), lane = tid & 63, wr = wid >> 2, wc = wid & 3, fr = lane & 15, fq = lane >> 4;
    const int K = g.K, nt = K / BK;
    unsigned voffA[2], voffB[2];
#pragma unroll
    for (int i = 0; i < 2; ++i) { int R, C; stage_rc(tid * 16 + i * 8192, R, C); const int Rb = Epi::PERM ? ((R & ~31) + perm32(R & 31)) : R;
        voffA[i] = (unsigned)(R * K + C) * 2u; voffB[i] = (unsigned)(Rb * K + C) * 2u; }
    const size_t kstep = (size_t)(BK * 2);
    const size_t hstep = (size_t)HALF * K * 2;
    const size_t tstep = 2 * hstep;
    const unsigned ldsw = (unsigned)wid * 1024u;
    const int aoff = lds_byte(wr * 64 + fr, fq * 8), boff = lds_byte(wc * 32 + fr, fq * 8);
#define PG8_SA(b, h) (((b) * 2 + (h)) * HTB)
#define PG8_SB(b, h) ((4 + (b) * 2 + (h)) * HTB)
#define PG8_STAGE(bufoff, gbase, voff) do { _Pragma("unroll") for (int _i = 0; _i < 2; ++_i) \
        __builtin_amdgcn_global_load_lds((const unsigned*)((const char*)(gbase) + (voff)[_i]), (PG8_LAS unsigned*)(lds + (bufoff) + ldsw + _i * 8192), 16, 0, 0); } while (0)
#define PG8_LDA(dst, b, h) do { _Pragma("unroll") for (int m = 0; m < 4; ++m) _Pragma("unroll") for (int k = 0; k < 2; ++k) dst[m][k] = *(const PG8_LAS bf16x8*)(lds + PG8_SA(b, h) + aoff + m * 2048 + k * 1024); } while (0)
#define PG8_LDB(dst, b, h) do { _Pragma("unroll") for (int n = 0; n < 2; ++n) _Pragma("unroll") for (int k = 0; k < 2; ++k) dst[n][k] = *(const PG8_LAS bf16x8*)(lds + PG8_SB(b, h) + boff + n * 2048 + k * 1024); } while (0)
#define PG8_MMA(ai, bj, At, Bt) do { __builtin_amdgcn_s_setprio(1); _Pragma("unroll") for (int m = 0; m < 4; ++m) _Pragma("unroll") for (int n = 0; n < 2; ++n) _Pragma("unroll") for (int k = 0; k < 2; ++k) \
        acc[ai][bj][m][n] = __builtin_amdgcn_mfma_f32_16x16x32_bf16(Bt[n][k], At[m][k], acc[ai][bj][m][n], 0, 0, 0); __builtin_amdgcn_s_setprio(0); } while (0)
#define PG8_WAIT_V(n) asm volatile("s_waitcnt vmcnt(" #n ")" ::: "memory")
#define PG8_WAIT_L(n) asm volatile("s_waitcnt lgkmcnt(" #n ")" ::: "memory")
#define PG8_BAR __builtin_amdgcn_s_barrier()
#define PG8_SCHED __builtin_amdgcn_sched_barrier(0)
    Unit cur, nxt; int ui = 0;
    if (!S.next(0, cur)) return;
    f32x4 acc[2][2][4][2];
#pragma unroll
    for (int a = 0; a < 2; ++a)
#pragma unroll
        for (int b = 0; b < 2; ++b)
#pragma unroll
            for (int m = 0; m < 4; ++m)
#pragma unroll
                for (int n = 0; n < 2; ++n) acc[a][b][m][n] = (f32x4){0.f, 0.f, 0.f, 0.f};
    bf16x8 At[4][2], B0[2][2], B1[2][2];
    const char* cA = (const char*)g.A + (size_t)cur.pm * tstep; const char* cB = (const char*)g.Bt + (size_t)cur.pn * tstep;
    S.a_ready(cur);
    if constexpr (SP2) {
        PG8_STAGE(PG8_SB(0, 0), cB, voffB); PG8_STAGE(PG8_SB(0, 1), cB + hstep, voffB); PG8_STAGE(PG8_SA(0, 0), cA, voffA); PG8_STAGE(PG8_SA(0, 1), cA + hstep, voffA);
        if (wr == 1) PG8_BAR;
        PG8_WAIT_V(2); PG8_BAR;
        PG8_STAGE(PG8_SB(1, 0), cB + kstep, voffB); PG8_STAGE(PG8_SA(1, 0), cA + kstep, voffA); PG8_STAGE(PG8_SB(1, 1), cB + hstep + kstep, voffB);
        PG8_WAIT_V(6); PG8_BAR;
    } else {
        PG8_STAGE(PG8_SB(0, 0), cB, voffB); PG8_STAGE(PG8_SA(0, 0), cA, voffA); PG8_STAGE(PG8_SB(0, 1), cB + hstep, voffB); PG8_STAGE(PG8_SA(0, 1), cA + hstep, voffA);
        if (wr == 1) PG8_BAR;
        PG8_WAIT_V(4); PG8_BAR;
        PG8_STAGE(PG8_SB(1, 0), cB + kstep, voffB); PG8_STAGE(PG8_SA(1, 0), cA + kstep, voffA); PG8_STAGE(PG8_SB(1, 1), cB + hstep + kstep, voffB);
        PG8_WAIT_V(6); PG8_BAR;
    }
    for (;;) {
        const bool has_next = S.next(ui + 1, nxt);
        const char* nA = has_next ? (const char*)g.A + (size_t)nxt.pm * tstep : cA; const char* nB = has_next ? (const char*)g.Bt + (size_t)nxt.pn * tstep : cB;
        for (int t = 0; t < nt; t += 2) {
            const bool last = (t == nt - 2);
            const char* a1 = cA + (size_t)(t + 1) * kstep;
            const char* a2 = last ? nA : cA + (size_t)(t + 2) * kstep; const char* b2 = last ? nB : cB + (size_t)(t + 2) * kstep;
            const char* a3 = a2 + kstep; const char* b3 = b2 + kstep;
            if (last && has_next) S.a_ready(nxt);
            if constexpr (SP2) {
            PG8_LDB(B0, 0, 0); PG8_LDB(B1, 0, 1); PG8_SCHED; PG8_LDA(At, 0, 0); PG8_STAGE(PG8_SA(1, 1), a1 + hstep, voffA);
            PG8_WAIT_V(8); PG8_WAIT_L(0); PG8_BAR; PG8_MMA(0, 0, At, B0); PG8_MMA(0, 1, At, B1); PG8_BAR; PG8_SCHED;
            PG8_LDA(At, 0, 1); PG8_STAGE(PG8_SB(0, 0), b2, voffB); PG8_STAGE(PG8_SB(0, 1), b2 + hstep, voffB); PG8_STAGE(PG8_SA(0, 0), a2, voffA);
            PG8_WAIT_V(8); PG8_WAIT_L(0); PG8_BAR; PG8_MMA(1, 0, At, B0); PG8_MMA(1, 1, At, B1); PG8_BAR; PG8_SCHED;
            PG8_LDB(B0, 1, 0); PG8_LDB(B1, 1, 1); PG8_SCHED; PG8_LDA(At, 1, 0); PG8_STAGE(PG8_SA(0, 1), a2 + hstep, voffA);
            PG8_WAIT_V(8); PG8_WAIT_L(0); PG8_BAR; PG8_MMA(0, 0, At, B0); PG8_MMA(0, 1, At, B1); PG8_BAR; PG8_SCHED;
            PG8_LDA(At, 1, 1); PG8_STAGE(PG8_SB(1, 0), b3, voffB); PG8_STAGE(PG8_SB(1, 1), b3 + hstep, voffB); PG8_STAGE(PG8_SA(1, 0), a3, voffA);
            PG8_WAIT_V(8); PG8_WAIT_L(0); PG8_BAR; PG8_MMA(1, 0, At, B0); PG8_MMA(1, 1, At, B1); PG8_BAR; PG8_SCHED;
            } else {
            PG8_LDB(B0, 0, 0); PG8_SCHED; PG8_LDA(At, 0, 0); PG8_STAGE(PG8_SA(1, 1), a1 + hstep, voffA);
            PG8_WAIT_L(8); PG8_BAR; PG8_WAIT_L(0); PG8_MMA(0, 0, At, B0); PG8_BAR; PG8_SCHED;
            PG8_LDB(B1, 0, 1); PG8_STAGE(PG8_SB(0, 0), b2, voffB);
            PG8_BAR; PG8_WAIT_L(0); PG8_MMA(0, 1, At, B1); PG8_BAR;
            PG8_LDA(At, 0, 1); PG8_STAGE(PG8_SA(0, 0), a2, voffA);
            PG8_BAR; PG8_WAIT_L(0); PG8_MMA(1, 0, At, B0); PG8_BAR; PG8_SCHED;
            PG8_STAGE(PG8_SB(0, 1), b2 + hstep, voffB);
            PG8_WAIT_V(6); PG8_BAR; PG8_MMA(1, 1, At, B1); PG8_BAR;
            PG8_LDB(B0, 1, 0); PG8_SCHED; PG8_LDA(At, 1, 0); PG8_STAGE(PG8_SA(0, 1), a2 + hstep, voffA);
            PG8_WAIT_L(8); PG8_BAR; PG8_WAIT_L(0); PG8_MMA(0, 0, At, B0); PG8_BAR; PG8_SCHED;
            PG8_LDB(B1, 1, 1); PG8_STAGE(PG8_SB(1, 0), b3, voffB);
            PG8_BAR; PG8_WAIT_L(0); PG8_MMA(0, 1, At, B1); PG8_BAR;
            PG8_LDA(At, 1, 1); PG8_STAGE(PG8_SA(1, 0), a3, voffA);
            PG8_BAR; PG8_WAIT_L(0); PG8_MMA(1, 0, At, B0); PG8_BAR; PG8_SCHED;
            PG8_STAGE(PG8_SB(1, 1), b3 + hstep, voffB);
            PG8_WAIT_V(6); PG8_BAR; PG8_MMA(1, 1, At, B1); PG8_BAR;
            }
        }
        if constexpr (ALIGN_EPI) { if (wr == 0) PG8_BAR; }
        if constexpr (!Epi::AFTER_DRAIN) { E(acc, cur, wr, wc, fr, fq); S.done(cur); }
        if (!has_next) break;
#pragma unroll
        for (int a = 0; a < 2; ++a)
#pragma unroll
            for (int b = 0; b < 2; ++b)
#pragma unroll
                for (int m = 0; m < 4; ++m)
#pragma unroll
                    for (int n = 0; n < 2; ++n) acc[a][b][m][n] = (f32x4){0.f, 0.f, 0.f, 0.f};
        cur = nxt; cA = nA; cB = nB; ++ui;
        if constexpr (ALIGN_EPI) { if (wr == 1) PG8_BAR; }
    }
    PG8_WAIT_V(0);
    if constexpr (!ALIGN_EPI) { if (wr == 0) PG8_BAR; }
    PG8_BAR;
    if constexpr (Epi::AFTER_DRAIN) { E.fused(acc, cur, wr, wc, fr, fq, lds, wid, lane); S.done(cur); }
#undef PG8_SA
#undef PG8_SB
#undef PG8_STAGE
#undef PG8_LDA
#undef PG8_LDB
#undef PG8_MMA
#undef PG8_WAIT_V
#undef PG8_WAIT_L
#undef PG8_BAR
#undef PG8_SCHED
}
}

#include <hip/hip_bf16.h>
namespace attn_body {
using bf16=__hip_bfloat16;
using bf16x8=__attribute__((ext_vector_type(8)))short;
using s16x4=__attribute__((ext_vector_type(4)))short;
using f32x16=__attribute__((ext_vector_type(16)))float;
using u32x4=__attribute__((ext_vector_type(4)))unsigned;
constexpr int D=64,PQ=1024,PO=2048;
constexpr int NW=8,QBLK=32,QB=QBLK*NW,KVBLK=64,KPRE=128;
__device__ __forceinline__ int crow(int r,int hi){return (r&3)+8*(r>>2)+4*hi;}
#define SBAR() __builtin_amdgcn_sched_barrier(0)
__device__ __forceinline__ void cmask(f32x16&p0,f32x16&p1,int jb,int qrel,int hi){
  const float NEG=-INFINITY; int hv=hi; asm volatile("":"+v"(hv)); int kb=64*jb+4*hv;
  #pragma unroll
  for(int r=0;r<16;++r){int kv=kb+(r&3)+8*(r>>2); if(kv>qrel)p0[r]=NEG; if(kv+32>qrel)p1[r]=NEG;}
}

constexpr int NSLOT=3, SLOTB=8192;
constexpr int LDS_K=0, LDS_V=NSLOT*SLOTB, LDS_WS=2*NSLOT*SLOTB, LDS_OST=LDS_WS+NW*64*4, LDS_BYTES=LDS_OST+NW*4096;
constexpr float C2=0.125f*1.4426950408889634f;
__device__ __forceinline__ void glds16(const void*gsrc,unsigned lds_dst){unsigned keep;
  asm volatile("s_mov_b32 %0, m0\n\ts_mov_b32 m0, %2\n\ts_nop 0\n\tglobal_load_lds_dwordx4 %1, off\n\ts_mov_b32 m0, %0":"=&s"(keep):"v"(gsrc),"s"(lds_dst):"memory");}
__device__ __forceinline__ float max3f(float a,float b,float c){float r;asm("v_max3_f32 %0, %1, %2, %3":"=v"(r):"v"(a),"v"(b),"v"(c));return r;}
__device__ __forceinline__ float max2f(float a,float b){float r;asm("v_max_f32_e32 %0, %1, %2":"=v"(r):"v"(a),"v"(b));return r;}
__device__ __forceinline__ float fadd_s(float a,float b){float r;asm("v_add_f32_e32 %0, %1, %2":"=v"(r):"v"(a),"v"(b));return r;}
__device__ __forceinline__ float fsub_s(float a,float b){float r;asm("v_sub_f32_e32 %0, %1, %2":"=v"(r):"v"(a),"v"(b));return r;}
typedef float f32x2_t __attribute__((ext_vector_type(2))); typedef __bf16 bf16x2_t __attribute__((ext_vector_type(2)));
__device__ __forceinline__ unsigned cvtpk_s(float lo,float hi){f32x2_t v={lo,hi};bf16x2_t b=__builtin_convertvector(v,bf16x2_t);return __builtin_bit_cast(unsigned,b);}
#define WAIT_BAR(N) asm volatile("s_waitcnt vmcnt(" #N ") lgkmcnt(0)\n\ts_barrier":::"memory")

__device__ __forceinline__ void qkt(f32x16&p0,f32x16&p1,const char*Kslot,const bf16x8*qr,const f32x16&negm,int r32,int hi){
  const char*kb=Kslot+hi*1024+r32*16;
  #pragma unroll
  for(int d0=0;d0<4;++d0){
    const bf16x8 b0=*reinterpret_cast<const bf16x8*>(kb+d0*2048);
    const bf16x8 b1=*reinterpret_cast<const bf16x8*>(kb+d0*2048+512);
    if(d0==0){p0=__builtin_amdgcn_mfma_f32_32x32x16_bf16(b0,qr[0],negm,0,0,0);p1=__builtin_amdgcn_mfma_f32_32x32x16_bf16(b1,qr[0],negm,0,0,0);}
    else{p0=__builtin_amdgcn_mfma_f32_32x32x16_bf16(b0,qr[d0],p0,0,0,0);p1=__builtin_amdgcn_mfma_f32_32x32x16_bf16(b1,qr[d0],p1,0,0,0);}}
}
typedef __attribute__((address_space(3))) const char* lds_cptr;
typedef short v4i16_t __attribute__((ext_vector_type(4)));
__device__ __forceinline__ void kload8(bf16x8*kf,lds_cptr kp){
  kf[0]=*(const __attribute__((address_space(3))) bf16x8*)(kp);      kf[1]=*(const __attribute__((address_space(3))) bf16x8*)(kp+512);
  kf[2]=*(const __attribute__((address_space(3))) bf16x8*)(kp+2048); kf[3]=*(const __attribute__((address_space(3))) bf16x8*)(kp+2560);
  kf[4]=*(const __attribute__((address_space(3))) bf16x8*)(kp+4096); kf[5]=*(const __attribute__((address_space(3))) bf16x8*)(kp+4608);
  kf[6]=*(const __attribute__((address_space(3))) bf16x8*)(kp+6144); kf[7]=*(const __attribute__((address_space(3))) bf16x8*)(kp+6656);
}
__device__ __forceinline__ void kload2(bf16x8*kf,lds_cptr kp,int j){ kf[2*j]=*(const __attribute__((address_space(3))) bf16x8*)(kp+j*2048); kf[2*j+1]=*(const __attribute__((address_space(3))) bf16x8*)(kp+j*2048+512); }
__device__ __forceinline__ s16x4 vtr(lds_cptr p){ return __builtin_bit_cast(s16x4,__builtin_amdgcn_ds_read_tr16_b64_v4i16((__attribute__((address_space(3))) v4i16_t*)p)); }
__device__ __forceinline__ float rowmax(const f32x16&p0,const f32x16&p1){
  float a=max3f(p0[0],p0[1],p1[0]),b=max3f(p0[2],p0[3],p1[1]);a=max3f(a,p1[2],p1[3]);
  #pragma unroll
  for(int r=4;r<16;r+=4){a=max3f(a,p0[r],p0[r+1]);b=max3f(b,p0[r+2],p0[r+3]);a=max3f(a,p1[r],p1[r+1]);b=max3f(b,p1[r+2],p1[r+3]);}
  const float m=max2f(a,b);
  auto rr=__builtin_amdgcn_permlane32_swap(__float_as_uint(m),__float_as_uint(m),false,false);
  return max2f(__uint_as_float(rr[0]),__uint_as_float(rr[1]));
}
__device__ __forceinline__ void pv(f32x16*o,int vb,bf16x8 pa0,bf16x8 pa1,bf16x8 pa2,bf16x8 pa3){
  #pragma unroll
  for(int d0=0;d0<2;++d0){s16x4 lo[4],hi[4];
    #pragma unroll
    for(int ks=0;ks<4;++ks){
      asm volatile("ds_read_b64_tr_b16 %0,%1 offset:%c2":"=&v"(lo[ks]):"v"(vb),"i"(d0*4096+ks*1024):"memory");
      asm volatile("ds_read_b64_tr_b16 %0,%1 offset:%c2":"=&v"(hi[ks]):"v"(vb),"i"(d0*4096+ks*1024+512):"memory");}
    asm volatile("s_waitcnt lgkmcnt(0)":::"memory");SBAR();
    #define PK(k) (bf16x8){lo[k][0],lo[k][1],lo[k][2],lo[k][3],hi[k][0],hi[k][1],hi[k][2],hi[k][3]}
    o[d0]=__builtin_amdgcn_mfma_f32_32x32x16_bf16(pa0,PK(0),o[d0],0,0,0);
    o[d0]=__builtin_amdgcn_mfma_f32_32x32x16_bf16(pa1,PK(1),o[d0],0,0,0);
    o[d0]=__builtin_amdgcn_mfma_f32_32x32x16_bf16(pa2,PK(2),o[d0],0,0,0);
    o[d0]=__builtin_amdgcn_mfma_f32_32x32x16_bf16(pa3,PK(3),o[d0],0,0,0);
    #undef PK
  }
}

#ifndef ATTN_STORE16
#define ATTN_STORE16(p,v) (*(u32x4*)(p)=(v))
#endif
template<int THRL> __device__ __forceinline__ void attn_unit(int qrow0,int krow0,int qb,int qcol,int vcol,int ocol,float sl2,const bf16*Q,const bf16*__restrict__ K,const bf16*__restrict__ V,bf16*O,char*shm){
  const int tid=threadIdx.x; int lane_=tid&63; asm volatile("":"+v"(lane_));
  const int lane=lane_,r32=lane&31,hi=lane>>5; const int wid=__builtin_amdgcn_readfirstlane(tid>>6);
  const int q0=qb*QB; constexpr int DM=PQ;
  const bf16*Qw=Q+(long)(qrow0+wid*QBLK)*DM+qcol;
  const bf16*Kh=K+(long)krow0*DM+qcol,*Vh=V+(long)krow0*DM+vcol;
  const float pos_last=(float)(16+q0+255), lanepart=sl2*(float)(4*hi);
  const unsigned lds0=(unsigned)(uintptr_t)shm;
  float*wsf=(float*)(shm+LDS_WS)+wid*64;
  const bf16*ksrc=Kh+(long)lane*DM+wid*8;
  const bf16*vsrc=Vh+(long)(16*(wid&3)+(lane>>2))*DM+(wid>>2)*32+(lane&3)*8;
  const unsigned kdst=lds0+LDS_K+wid*1024, vdst=lds0+LDS_V+wid*1024;
  #define DMA_K(t,slot) glds16(ksrc+(long)(t)*KVBLK*DM,(unsigned)__builtin_amdgcn_readfirstlane(kdst+(slot)))
  #define DMA_V(t,slot) glds16(vsrc+(long)(t)*KVBLK*DM,(unsigned)__builtin_amdgcn_readfirstlane(vdst+(slot)))
  const int vb0=(int)(lds0+LDS_V)+((lane>>4)&1)*32+(lane&3)*8+(4*hi+((lane&15)>>2))*64;
  const char*Kbase=shm+LDS_K; bf16x8 kf[8];
  const lds_cptr shm3=(lds_cptr)shm; const lds_cptr kp0=shm3+LDS_K+hi*1024+r32*16; const lds_cptr vp0=shm3+LDS_V+((lane>>4)&1)*32+(lane&3)*8+(4*hi+((lane&15)>>2))*64;
  const int NT=(KPRE+q0+QB)/KVBLK;
  DMA_K(0,0);DMA_V(0,0);DMA_K(1,SLOTB);
  bf16x8 qr[4];
  #pragma unroll
  for(int d0=0;d0<4;++d0)qr[d0]=*reinterpret_cast<const bf16x8*>(&Qw[(long)r32*DM+d0*16+hi*8]);
  float mhat=0.f,l_reg=0.f;f32x16 o[2];o[0]=f32x16{};o[1]=f32x16{};const f32x16 negm=f32x16{};
  const int qrel=wid*QBLK+r32;
  #define CMASK(P0,P1,t) do{int jb_=(t)-(NT-4); if(jb_>=0)cmask(P0,P1,jb_,qrel,hi);}while(0)
  #define ABIAS(P0,P1,t) do{ const float tb_=((t)==1)?-INFINITY:sl2*((float)(64*(t)-112)-pos_last); const float b0_=tb_+lanepart-mhat, b1_=b0_+32.f*sl2; \
    _Pragma("unroll") for(int r=0;r<16;++r){ const float cr_=(float)((r&3)+8*(r>>2)); P0[r]=fmaf(sl2,cr_,P0[r]+b0_); P1[r]=fmaf(sl2,cr_,P1[r]+b1_);} }while(0)
  #define ABIAS0(P0,P1) do{ const float b0_=lanepart-sl2*pos_last; \
    _Pragma("unroll") for(int r=0;r<16;++r){ const float cr_=(float)((r&3)+8*(r>>2)); P0[r]=(r<8)?fmaf(sl2,cr_,P0[r]+b0_):-INFINITY; P1[r]=-INFINITY;} }while(0)
  bool resc=false;
  #define START(P0,P1) do{ const float rm=rowmax(P0,P1); resc=false; \
    { const float dl=rm; mhat=fadd_s(mhat,dl); \
      _Pragma("unroll") for(int r=0;r<16;++r){P0[r]=fsub_s(P0[r],dl);P1[r]=fsub_s(P1[r],dl);} \
      } \
    _Pragma("unroll") for(int r=0;r<16;++r)P0[r]=__builtin_amdgcn_exp2f(P0[r]); }while(0)
  #define RESC() do{ if(resc){ asm volatile("s_waitcnt lgkmcnt(0)":::"memory"); \
      _Pragma("unroll") for(int d_=0;d_<2;++d_) _Pragma("unroll") for(int r=0;r<16;++r)o[d_][r]*=wsf[crow(r,hi)]; } }while(0)
  f32x16 pA0,pA1,pB0,pB1;
  int sl_prev=0,sl_cur=0,sl_next=SLOTB;
  #define ROT() do{sl_prev=sl_cur;sl_cur=sl_next;sl_next=(sl_next==(NSLOT-1)*SLOTB)?0:sl_next+SLOTB;}while(0)
  DMA_K(2,2*SLOTB);
  WAIT_BAR(3);
  qkt(pA0,pA1,Kbase,qr,negm,r32,hi);asm volatile("s_nop 15\n\ts_nop 7":"+v"(pA0),"+v"(pA1));ABIAS0(pA0,pA1);
  START(pA0,pA1);
  _Pragma("unroll") for(int r=0;r<16;++r)pA1[r]=__builtin_amdgcn_exp2f(pA1[r]);
  WAIT_BAR(0);
  DMA_K(3,0);DMA_V(1,SLOTB);
  ROT();
  kload8(kf,kp0+sl_cur);
  WAIT_BAR(2);
  s16x4 vlo[8],vhi[8]; u32x4 pw0,pw1,pw2,pw3;
  #define PKW(P,B) cvtpk_s(P[B],P[B+1])
  #define PAF(k) __builtin_bit_cast(bf16x8,pw##k)
  #define VFR(i) (bf16x8){vlo[i][0],vlo[i][1],vlo[i][2],vlo[i][3],vhi[i][0],vhi[i][1],vhi[i][2],vhi[i][3]}
  #define PIN(x) asm volatile("":"+v"(x))
  #define MX3(a,b,c) __builtin_fmaxf(__builtin_fmaxf((a),(b)),(c))
  #define GAPA(MF,A0,A1,A2,A3,W0,W1,PW) do{ MF; sacc+=A0; sacc+=A1; sacc+=A2; sacc+=A3; PIN(sacc); W0; W1; PIN(PW); SBAR(); }while(0)
  #define EX(v) __builtin_amdgcn_exp2f(v)
  #define GAPB(MF,X,B) do{ MF; X[B]=EX(X[B]); X[B+1]=EX(X[B+1]); X[B+2]=EX(X[B+2]); X[B+3]=EX(X[B+3]); PIN(X); SBAR(); }while(0)
  #define VRD(i) do{ vlo[i]=vtr(vp_+(((i)>>2)*4096+((i)&3)*1024)); vhi[i]=vtr(vp_+(((i)>>2)*4096+((i)&3)*1024+512)); }while(0)
  #define KRD(G,j) do{ if(G){ kload2(kf,kp0+sl_next,j); SBAR(); } }while(0)
  #define STEP(C0,C1,P0,P1,t,GK,GV,GL) do{ SBAR(); \
    const lds_cptr vp_=vp0+sl_prev; \
    VRD(0); SBAR(); float sacc=(P0[0]+P0[1]); \
    GAPA(C0=__builtin_amdgcn_mfma_f32_32x32x16_bf16(kf[0],qr[0],negm,0,0,0), P0[2],P0[3],P0[4],P0[5],     pw0[0]=PKW(P0,0), pw0[1]=PKW(P0,2), pw0); \
    VRD(4); SBAR(); GAPA(C1=__builtin_amdgcn_mfma_f32_32x32x16_bf16(kf[1],qr[0],negm,0,0,0), P0[6],P0[7],P0[8],P0[9],     pw0[2]=PKW(P0,4), pw0[3]=PKW(P0,6), pw0); \
    VRD(1); SBAR(); GAPA(C0=__builtin_amdgcn_mfma_f32_32x32x16_bf16(kf[2],qr[1],C0,0,0,0),   P0[10],P0[11],P0[12],P0[13], pw1[0]=PKW(P0,8), pw1[1]=PKW(P0,10), pw1); \
    VRD(5); SBAR(); GAPA(C1=__builtin_amdgcn_mfma_f32_32x32x16_bf16(kf[3],qr[1],C1,0,0,0),   P0[14],P0[15],P1[0],P1[1],   pw1[2]=PKW(P0,12),pw1[3]=PKW(P0,14), pw1); \
    VRD(2); SBAR(); GAPA(C0=__builtin_amdgcn_mfma_f32_32x32x16_bf16(kf[4],qr[2],C0,0,0,0),   P1[2],P1[3],P1[4],P1[5],     pw2[0]=PKW(P1,0), pw2[1]=PKW(P1,2), pw2); \
    VRD(6); SBAR(); GAPA(C1=__builtin_amdgcn_mfma_f32_32x32x16_bf16(kf[5],qr[2],C1,0,0,0),   P1[6],P1[7],P1[8],P1[9],     pw2[2]=PKW(P1,4), pw2[3]=PKW(P1,6), pw2); \
    VRD(3); SBAR(); GAPA(C0=__builtin_amdgcn_mfma_f32_32x32x16_bf16(kf[6],qr[3],C0,0,0,0),   P1[10],P1[11],P1[12],P1[13], pw3[0]=PKW(P1,8), pw3[1]=PKW(P1,10), pw3); \
    VRD(7); SBAR(); GAPA(C1=__builtin_amdgcn_mfma_f32_32x32x16_bf16(kf[7],qr[3],C1,0,0,0),   P1[14],P1[15],0.f,0.f,       pw3[2]=PKW(P1,12),pw3[3]=PKW(P1,14), pw3); \
    l_reg+=sacc; \
    if(GK){DMA_K((t)+3,sl_cur);} if(GV){DMA_V((t)+1,sl_next);} \
    ABIAS(C0,C1,t); CMASK(C0,C1,t); \
    { float a=MX3(C0[0],C0[1],C1[0]),b=MX3(C0[2],C0[3],C1[1]); a=MX3(a,C1[2],C1[3]); \
      _Pragma("unroll") for(int r=4;r<16;r+=4){a=MX3(a,C0[r],C0[r+1]);b=MX3(b,C0[r+2],C0[r+3]);a=MX3(a,C1[r],C1[r+1]);b=MX3(b,C1[r+2],C1[r+3]);} \
      float rm=__builtin_fmaxf(a,b); { auto rr=__builtin_amdgcn_permlane32_swap(__float_as_uint(rm),__float_as_uint(rm),false,false); rm=__builtin_fmaxf(__uint_as_float(rr[0]),__uint_as_float(rr[1])); } \
      resc=false; \
      if(__builtin_expect(__any(rm>(float)THRL),0)){ const float dl=__builtin_fmaxf(rm,0.f); mhat+=dl; \
        _Pragma("unroll") for(int r=0;r<16;++r){C0[r]-=dl;C1[r]-=dl;} \
        const float f=__builtin_amdgcn_exp2f(-dl); l_reg*=f; if(hi==0)wsf[r32]=f; resc=true; } } \
    SBAR(); \
    GAPB(o[0]=__builtin_amdgcn_mfma_f32_32x32x16_bf16(PAF(0),VFR(0),o[0],0,0,0), C0,0); \
    GAPB(o[1]=__builtin_amdgcn_mfma_f32_32x32x16_bf16(PAF(0),VFR(4),o[1],0,0,0), C0,4); \
    KRD(GL,0); GAPB(o[0]=__builtin_amdgcn_mfma_f32_32x32x16_bf16(PAF(1),VFR(1),o[0],0,0,0), C0,8); \
    KRD(GL,1); GAPB(o[1]=__builtin_amdgcn_mfma_f32_32x32x16_bf16(PAF(1),VFR(5),o[1],0,0,0), C0,12); \
    KRD(GL,2); GAPB(o[0]=__builtin_amdgcn_mfma_f32_32x32x16_bf16(PAF(2),VFR(2),o[0],0,0,0), C1,0); \
    KRD(GL,3); GAPB(o[1]=__builtin_amdgcn_mfma_f32_32x32x16_bf16(PAF(2),VFR(6),o[1],0,0,0), C1,4); \
    GAPB(o[0]=__builtin_amdgcn_mfma_f32_32x32x16_bf16(PAF(3),VFR(3),o[0],0,0,0), C1,8); \
    GAPB(o[1]=__builtin_amdgcn_mfma_f32_32x32x16_bf16(PAF(3),VFR(7),o[1],0,0,0), C1,12); \
    }while(0)
  int t=1;
  #undef CMASK
  #define CMASK(P0,P1,t) do{}while(0)
  for(;t+5<NT;t+=2){
    STEP(pB0,pB1,pA0,pA1,t,true,true,true);     WAIT_BAR(2); RESC(); ROT();
    STEP(pA0,pA1,pB0,pB1,t+1,true,true,true);   WAIT_BAR(2); RESC(); ROT();
  }
  #undef CMASK
  #define CMASK(P0,P1,t) do{int jb_=(t)-(NT-4); if(jb_>=0)cmask(P0,P1,jb_,qrel,hi);}while(0)
  #define ENDW(tt) do{ if((tt)+3<NT){WAIT_BAR(2);} else if((tt)+2<NT){WAIT_BAR(1);} else {WAIT_BAR(0);} }while(0)
  for(;t+1<NT;t+=2){
    STEP(pB0,pB1,pA0,pA1,t,(t+3<NT),(t+1<NT),(t+1<NT));       ENDW(t);   RESC(); ROT();
    STEP(pA0,pA1,pB0,pB1,t+1,(t+4<NT),(t+2<NT),(t+2<NT));     ENDW(t+1); RESC(); ROT();
  }
  STEP(pB0,pB1,pA0,pA1,NT-1,false,false,false); RESC();
  { float sacc=pB0[0]+pB0[1]; _Pragma("unroll") for(int r=2;r<16;++r)sacc+=pB0[r]; _Pragma("unroll") for(int r=0;r<16;++r)sacc+=pB1[r]; l_reg+=sacc;
    pw0=(u32x4){PKW(pB0,0),PKW(pB0,2),PKW(pB0,4),PKW(pB0,6)};pw1=(u32x4){PKW(pB0,8),PKW(pB0,10),PKW(pB0,12),PKW(pB0,14)};pw2=(u32x4){PKW(pB1,0),PKW(pB1,2),PKW(pB1,4),PKW(pB1,6)};pw3=(u32x4){PKW(pB1,8),PKW(pB1,10),PKW(pB1,12),PKW(pB1,14)};
    SBAR(); pv(o,vb0+sl_cur,PAF(0),PAF(1),PAF(2),PAF(3)); }
  #undef PKW
  #undef PAF
  #undef VFR
  #undef PIN
  #undef MX3
  #undef GAPA
  #undef GAPB
  #undef EX
  #undef VRD
  #undef KRD
  #undef STEP
  #undef ENDW
  { int lane_e=lane; asm volatile("":"+v"(lane_e)); const int lane=lane_e,r32=lane&31,hi=lane>>5;
  {auto rr=__builtin_amdgcn_permlane32_swap(__float_as_uint(l_reg),__float_as_uint(l_reg),false,false);l_reg=__uint_as_float(rr[0])+__uint_as_float(rr[1]);}
  if(hi==0)wsf[32+r32]=l_reg;asm volatile("s_waitcnt lgkmcnt(0)":::"memory");
  float rli[16];
  #pragma unroll
  for(int r=0;r<16;++r)rli[r]=__builtin_amdgcn_rcpf(wsf[32+crow(r,hi)]);
  bf16*Ow=O+(long)(qrow0+wid*QBLK)*PO+ocol;
  { bf16*stg=(bf16*)(shm+LDS_OST)+wid*2048;
    #pragma unroll
    for(int r=0;r<16;++r){const int orow=crow(r,hi);
      #pragma unroll
      for(int d0=0;d0<2;++d0)stg[orow*64+d0*32+r32]=__float2bfloat16(o[d0][r]*rli[r]);}
    asm volatile("s_waitcnt lgkmcnt(0)":::"memory");
    #pragma unroll
    for(int i=0;i<4;++i){const int row=i*8+(lane>>3),ch=lane&7; const u32x4 v=*(const u32x4*)(stg+row*64+ch*8); ATTN_STORE16(Ow+(long)row*PO+ch*8,v);} }
  }
  asm volatile("s_waitcnt lgkmcnt(0)\n\ts_barrier":::"memory");
  #undef DMA_K
  #undef DMA_V
  #undef CMASK
  #undef ABIAS
  #undef ABIAS0
  #undef START
  #undef RESC
  #undef ROT
}
constexpr int ATTN_LDS_BYTES=LDS_BYTES;
#undef SBAR
#undef WAIT_BAR
}

#define XB_TMO      128
#define XB_XCNT(j)  (256  + 64 * (j))
#define XB_XSUB(j)  (1280 + 64 * (j))
#define XB_XGEN(j)  (2304 + 64 * (j))
#define XB_TOP      3328
#define XB_TOPGEN   3392
#define XCD_BAR_WORDS 3456
#define XB_SPIN_CAP (1u << 18)

__device__ __forceinline__ unsigned xb_ld(unsigned* p)              { return __hip_atomic_load(p, __ATOMIC_RELAXED, __HIP_MEMORY_SCOPE_AGENT); }
__device__ __forceinline__ unsigned xb_add(unsigned* p, unsigned v) { return __hip_atomic_fetch_add(p, v, __ATOMIC_RELAXED, __HIP_MEMORY_SCOPE_AGENT); }
__device__ __forceinline__ unsigned xb_xcc_id() { return (unsigned)__builtin_amdgcn_s_getreg((3 << 11) | 20) & 0xFu; }
#define XB_SPIN(cond, bar) do { unsigned _sp = 0; while (cond) { __builtin_amdgcn_s_sleep(1); \
    if ((++_sp & 255u) == 0u) { if (xb_ld(&(bar)[XB_TMO])) break; if (_sp > XB_SPIN_CAP) { atomicAdd(&(bar)[XB_TMO], 1u); break; } } } } while (0)

struct XcdBarrier {
    unsigned* bar; unsigned x;
    volatile LAS unsigned* st;
};

__device__ __forceinline__ XcdBarrier xcd_barrier_post(unsigned* bar, volatile LAS unsigned* st) {
    XcdBarrier b; b.bar = bar; b.x = xb_xcc_id(); b.st = st;
    if (threadIdx.x == 0) (void)xb_add(&bar[XB_XCNT(b.x)], 1u);
    return b;
}
__device__ __forceinline__ void xcd_barrier_complete(unsigned* bar, unsigned x, unsigned& nloc, unsigned& nx) {
    const unsigned G = gridDim.x * gridDim.y * gridDim.z;
    unsigned sum, cnt, mine, sp = 0u;
    for (;;) {
        sum = 0u; cnt = 0u; mine = 0u;
#pragma unroll
        for (unsigned j = 0; j < 16; ++j) { const unsigned c = xb_ld(&bar[XB_XCNT(j)]); sum += c; cnt += (c > 0u) ? 1u : 0u; mine = (j == x) ? c : mine; }
        if (sum == G) break;
        __builtin_amdgcn_s_sleep(1);
        if ((++sp & 255u) == 0u) { if (xb_ld(&bar[XB_TMO])) break; if (sp > XB_SPIN_CAP) { atomicAdd(&bar[XB_TMO], 1u); break; } }
    }
    nloc = mine > 0u ? mine : 1u; nx = cnt > 0u ? cnt : 1u;
}

__device__ __forceinline__ void xcd_barrier(const XcdBarrier& b) {
    asm volatile("s_waitcnt vmcnt(0)" ::: "memory");
    __syncthreads();
    if (threadIdx.x == 0) {
        unsigned* bar = b.bar;
        __builtin_amdgcn_s_waitcnt(0);
        unsigned nloc = b.st[0], nx = b.st[1];
        if (nloc == 0u) { xcd_barrier_complete(bar, b.x, nloc, nx); b.st[0] = nloc; b.st[1] = nx; }
        const unsigned old = xb_add(&bar[XB_XSUB(b.x)], 1u);
        const unsigned gen = old / nloc;
        if (old + 1u == (gen + 1u) * nloc) {
            __builtin_amdgcn_fence(__ATOMIC_RELEASE, "agent");
            asm volatile("s_waitcnt vmcnt(0)" ::: "memory");
            const unsigned og = xb_add(&bar[XB_TOP], 1u);
            const unsigned tg = og / nx;
            if (og + 1u == (tg + 1u) * nx) xb_add(&bar[XB_TOPGEN], 1u);
            else XB_SPIN(xb_ld(&bar[XB_TOPGEN]) == tg, bar);
            __builtin_amdgcn_fence(__ATOMIC_ACQUIRE, "agent");
            xb_add(&bar[XB_XGEN(b.x)], 1u);
            asm volatile("s_waitcnt vmcnt(0)" ::: "memory");
        } else {
            XB_SPIN(xb_ld(&bar[XB_XGEN(b.x)]) == gen, bar);
            __builtin_amdgcn_fence(__ATOMIC_ACQUIRE, "agent");
            asm volatile("s_waitcnt vmcnt(0)" ::: "memory");
        }
    }
    __syncthreads();
}

#endif
constexpr int NWAVES = 8, NTHR = NWAVES * 64;
constexpr int RING_OFF = 0, RING_BYTES = 131072, LDSCTL_OFF = RING_BYTES, MISC_OFF = LDSCTL_OFF + 320, LDS_BYTES = 147456;
struct Frame {
    LAS unsigned char* lds;
    int tid, lane, wave, vcu, G;
    const void* const* in; float* out; unsigned char* ws;
    __device__ __forceinline__ const float* fin(int i) const { return (const float*)in[i]; }
};
struct Args { const void* in[N_IN]; float* out; unsigned char* ws; int ph_lo, ph_hi; };

__device__ __forceinline__ float* xrow_ptr(const Frame& F, int row) {
    if (row < MAIN) return F.out + OFF_YP + (size_t)row * DM;
    if (row < SMP0) return (float*)(F.ws + WS_XX) + (size_t)(row - META0) * DM;
    return F.out + OFF_YS + (size_t)(row - SMP0) * DM;
}
__device__ __forceinline__ const float* x0row_ptr(const Frame& F, int row) {
    if (row < MAIN) return F.fin(I_XP) + (size_t)row * DM;
    if (row < SMP0) return F.fin(I_META) + (size_t)(row - META0) * DM;
    return F.fin(I_XS) + (size_t)(row - SMP0) * DM;
}

__device__ __forceinline__ void wt_item(const float* W, int Nsrc, int srccol0, const float* scale, int k0, bf16* WT, int K, int dstrow0, LAS float* scr, int lane) {
#pragma unroll 8
    for (int i = 0; i < 32; ++i) { const int kk = 2 * i + (lane >> 5); float v = W[(size_t)(k0 + kk) * Nsrc + srccol0 + (lane & 31)]; if (scale) v *= scale[k0 + kk]; scr[kk * 33 + (lane & 31)] = v; }
    px_wave_sync();
    const int c = lane & 7;
#pragma unroll
    for (int j = 0; j < 4; ++j) { const int n = (lane >> 3) + 8 * j; const LAS float* s = scr + (8 * c) * 33 + n;
        u32x4 o; o.x = pk2(s[0 * 33], s[1 * 33]); o.y = pk2(s[2 * 33], s[3 * 33]); o.z = pk2(s[4 * 33], s[5 * 33]); o.w = pk2(s[6 * 33], s[7 * 33]);
        *(u32x4*)(WT + (size_t)(dstrow0 + n) * K + k0 + 8 * c) = o; }
    px_wave_sync();
}
constexpr int WI_IN0 = (DM / 64) * (NIN0 / 32), WI_SQ = (DM / 64) * (DM / 32), WI_GU = (DM / 64) * (NGU / 32), WI_D = (DFF / 64) * (DM / 32);
constexpr int WI_TOTAL = WI_IN0 + 4 * WI_SQ + 2 * WI_GU + 2 * WI_D;
__device__ __forceinline__ void p0_weight_item(const Frame& F, int it, LAS float* scr) {
    int r = it;
    if (r < WI_IN0) { const int nb = r % (NIN0 / 32), kb = r / (NIN0 / 32), n0 = nb * 32; int sc;
        if (n0 < 3072) sc = n0; else { const int j = (n0 - 3072) >> 8, o = (n0 - 3072) & 255; sc = (o < 128) ? 3072 + 128 * j + o : 4096 + 128 * j + (o - 128); }
        wt_item(F.fin(I_WIN0), NIN0, sc, F.fin(I_NMPRE), kb * 64, (bf16*)(F.ws + WS_WIN0), DM, n0, scr, F.lane); return; } r -= WI_IN0;
    if (r < WI_SQ) { wt_item(F.fin(I_WOUT0), DM, (r % 64) * 32, nullptr, (r / 64) * 64, (bf16*)(F.ws + WS_WOUT0), DM, (r % 64) * 32, scr, F.lane); return; } r -= WI_SQ;
    if (r < WI_SQ) { wt_item(F.fin(I_WIN1), DM, (r % 64) * 32, F.fin(I_NMPRE) + DM, (r / 64) * 64, (bf16*)(F.ws + WS_WIN1), DM, (r % 64) * 32, scr, F.lane); return; } r -= WI_SQ;
    if (r < WI_SQ) { wt_item(F.fin(I_WGLU), DM, (r % 64) * 32, nullptr, (r / 64) * 64, (bf16*)(F.ws + WS_WGLU), DM, (r % 64) * 32, scr, F.lane); return; } r -= WI_SQ;
    if (r < WI_SQ) { wt_item(F.fin(I_WOUT1), DM, (r % 64) * 32, nullptr, (r / 64) * 64, (bf16*)(F.ws + WS_WOUT1), DM, (r % 64) * 32, scr, F.lane); return; } r -= WI_SQ;
    if (r < 2 * WI_GU) { const int l = r / WI_GU; r -= l * WI_GU; const int nb = r % (NGU / 32), kb = r / (NGU / 32), n0 = nb * 32, j = n0 >> 8, o = n0 & 255;
        const float* W = (o < 128 ? F.fin(I_WG) : F.fin(I_WU)) + (size_t)l * DM * DFF;
        wt_item(W, DFF, 128 * j + (o & 127), F.fin(I_NFPRE) + l * DM, kb * 64, (bf16*)(F.ws + (l ? WS_WGU1 : WS_WGU0)), DM, n0, scr, F.lane); return; } r -= 2 * WI_GU;
    { const int l = r / WI_D; r -= l * WI_D; const int nb = r % 64, kb = r / 64;
        wt_item(F.fin(I_WD) + (size_t)l * DFF * DM, DM, nb * 32, nullptr, kb * 64, (bf16*)(F.ws + (l ? WS_WD1 : WS_WD0)), DFF, nb * 32, scr, F.lane); }
}
__device__ __forceinline__ void row_to_xb(const Frame& F, const float* xr, int row) {
    bf16* xb = (bf16*)(F.ws + WS_XB) + (size_t)row * DM; float* rs = (float*)(F.ws + WS_RS);
    f32x4 v[8]; float ss = 0.f;
#pragma unroll
    for (int j = 0; j < 8; ++j) { v[j] = *(const f32x4*)(xr + 4 * F.lane + 256 * j); ss += (v[j][0] * v[j][0] + v[j][1] * v[j][1]) + (v[j][2] * v[j][2] + v[j][3] * v[j][3]); }
    ss = wave_sum(ss);
#pragma unroll
    for (int j = 0; j < 8; ++j) { u32x2 w; w.x = pk2(v[j][0], v[j][1]); w.y = pk2(v[j][2], v[j][3]); *(u32x2*)(xb + 4 * F.lane + 256 * j) = w; }
    if (F.lane == 0) rs[row] = px_rsq(ss * (1.0f / DM) + EPSN);
}
__device__ __forceinline__ void p0_ssm_params(const Frame& F, int gp) {
    const int g = gp >> 6, p = gp & 63;
    const double are = F.fin(I_ARE)[gp], aim = F.fin(I_AIM)[gp], dt = exp((double)F.fin(I_LDT)[g]);
    const double mag = exp(are * dt); double sn, cs; sincos(aim * dt, &sn, &cs);
    const double abr = mag * cs, abi = mag * sn;
    const double nr = abr - 1.0, ni = abi, den = are * are + aim * aim;
    const double cr = (nr * are + ni * aim) / den, ci = (ni * are - nr * aim) / den;
    f32x2* AB = (f32x2*)(F.ws + WS_PAR + PAR_ABAR); AB[gp] = (f32x2){(float)abr, (float)abi};
    f32x2* PW = (f32x2*)(F.ws + WS_PAR + PAR_PW);
    for (int i = 0; i < 9; ++i) { const double k = 256.0 * i, mg = exp(are * dt * k); double s2, c2; sincos(aim * dt * k, &s2, &c2); PW[(g * 9 + i) * 64 + p] = (f32x2){(float)(mg * c2), (float)(mg * s2)}; }
    bf16* BBT = (bf16*)(F.ws + WS_PAR + PAR_BBT) + (size_t)g * 2048; bf16* CCT = (bf16*)(F.ws + WS_PAR + PAR_CCT) + (size_t)g * 2048;
    const int cb = (p >> 5) * 2, n = p & 31;
    for (int c = 0; c < 16; ++c) { const double br = F.fin(I_BRE)[gp * 16 + c], bi = F.fin(I_BIM)[gp * 16 + c];
        BBT[((cb + 0) * 32 + n) * 16 + c] = (bf16)f2bf((float)(cr * br - ci * bi)); BBT[((cb + 1) * 32 + n) * 16 + c] = (bf16)f2bf((float)(cr * bi + ci * br));
        CCT[c * 128 + 2 * p] = (bf16)f2bf(F.fin(I_CRE)[(g * 16 + c) * 64 + p]); CCT[c * 128 + 2 * p + 1] = (bf16)f2bf(-F.fin(I_CIM)[(g * 16 + c) * 64 + p]); }
}
__device__ __forceinline__ void p0_prologue(const Frame& F) {
    LAS float* scr = (LAS float*)(F.lds + RING_OFF + F.wave * 16384);
    const int gw = F.vcu * NWAVES + F.wave, NGW = F.G * NWAVES;
    for (int it = gw; it < WI_TOTAL; it += NGW) { if (!EMU_UNIT_OK(it)) continue; p0_weight_item(F, it, scr); }
    for (int row = gw; row < MP; row += NGW) { if (!EMU_UNIT_OK(WI_TOTAL + row)) continue;
        if (row < NREAL) row_to_xb(F, x0row_ptr(F, row), row);
        else { bf16* xb = (bf16*)(F.ws + WS_XB) + (size_t)row * DM; for (int j = 0; j < 4; ++j) *(u32x4*)(xb + 8 * F.lane + 512 * j) = (u32x4){0u, 0u, 0u, 0u}; if (F.lane == 0) ((float*)(F.ws + WS_RS))[row] = 0.f; } }
    for (int r = gw; r < NBATCH * (TPREF - NMETA); r += NGW) { if (!EMU_UNIT_OK(WI_TOTAL + MP + r)) continue;
        const int b = r / (TPREF - NMETA), j = NMETA + r % (TPREF - NMETA);
        bf16* kb = (bf16*)(F.ws + WS_KB) + (size_t)(b * KROWS + j) * 1024; bf16* vb = (bf16*)(F.ws + WS_VB) + (size_t)(b * KROWS + j) * 1024;
        for (int q = 0; q < 2; ++q) { *(u32x4*)(kb + 8 * F.lane + 512 * q) = (u32x4){0u, 0u, 0u, 0u}; *(u32x4*)(vb + 8 * F.lane + 512 * q) = (u32x4){0u, 0u, 0u, 0u}; } }
    const int gt = F.vcu * NTHR + F.tid, NGT = F.G * NTHR;
    for (int gp = gt; gp < 8192; gp += NGT) if (EMU_UNIT_OK(WI_TOTAL + MP + 1024 + gp)) p0_ssm_params(F, gp);
    if (gt == 0 && EMU_UNIT_OK(WI_TOTAL + MP + 1024 + 8192)) {
        const float* lq = F.fin(I_LQ); const float* lk = F.fin(I_LK); float s0 = 0.f, s1 = 0.f;
        for (int i = 0; i < 64; ++i) { s0 += lq[i] * lk[i]; s1 += lq[64 + i] * lk[64 + i]; }
        ((float*)(F.ws + WS_PAR + PAR_LAM))[0] = expf(s0) - expf(s1) + 0.2f; }
}

__device__ __forceinline__ void resid_row(const Frame& F, int row, const float* xold, const float* gpost, bool last) {
    const float* mr = (const float*)(F.ws + WS_M) + (size_t)row * DM; float* xn = xrow_ptr(F, row);
    f32x4 mv[8]; float ss = 0.f;
#pragma unroll
    for (int j = 0; j < 8; ++j) { mv[j] = *(const f32x4*)(mr + 4 * F.lane + 256 * j); ss += (mv[j][0] * mv[j][0] + mv[j][1] * mv[j][1]) + (mv[j][2] * mv[j][2] + mv[j][3] * mv[j][3]); }
    const float rm = px_rsq(wave_sum(ss) * (1.0f / DM) + EPSN);
    float s2 = 0.f; bf16* xb = (bf16*)(F.ws + WS_XB) + (size_t)row * DM;
#pragma unroll
    for (int j = 0; j < 8; ++j) { const int c = 4 * F.lane + 256 * j; const f32x4 xo = *(const f32x4*)(xold + c), gp = *(const f32x4*)(gpost + c);
        const f32x4 x = xo + mv[j] * rm * gp; *(f32x4*)(xn + c) = x; s2 += (x[0] * x[0] + x[1] * x[1]) + (x[2] * x[2] + x[3] * x[3]);
        if (!last) { u32x2 w; w.x = pk2(x[0], x[1]); w.y = pk2(x[2], x[3]); *(u32x2*)(xb + c) = w; } }
    s2 = wave_sum(s2);
    if (!last && F.lane == 0) ((float*)(F.ws + WS_RS))[row] = px_rsq(s2 * (1.0f / DM) + EPSN);
}
__device__ __forceinline__ void resid_phase(const Frame& F, const float* gpost, bool first, bool last) {
    const int gw = F.vcu * NWAVES + F.wave, NGW = F.G * NWAVES;
    for (int row = gw; row < NREAL; row += NGW) { if (!EMU_UNIT_OK(row)) continue;
        if (last && row >= META0 && row < SMP0) continue;
        resid_row(F, row, first ? x0row_ptr(F, row) : (const float*)xrow_ptr(F, row), gpost, last); }
}

struct ConvSeg { int kind, b, r0g, nrows, s0; };
__device__ __forceinline__ f32x2 conv_in(const Frame& F, const ConvSeg& sg, int i, int ch) {
    const bf16* Gb = (const bf16*)(F.ws + WS_G);
    if (i >= 0) { const unsigned w = *(const unsigned*)(Gb + (size_t)(sg.r0g + i) * 1024 + ch); return (f32x2){bf_lo(w), bf_hi(w)}; }
    if (sg.kind == 0) { const int s = sg.s0 + i;
        if (s >= 0) { const unsigned w = *(const unsigned*)(Gb + (size_t)(sg.r0g + i) * 1024 + ch); return (f32x2){bf_lo(w), bf_hi(w)}; }
        if (s >= -NMETA) { const unsigned w = *(const unsigned*)(Gb + (size_t)(META0 + NMETA + s) * 1024 + ch); return (f32x2){bf_lo(w), bf_hi(w)}; }
        return (f32x2){0.f, 0.f}; }
    if (sg.kind == 2) { const float* st = F.fin(I_SCONV) + ((size_t)sg.b * 30 + (30 + i)) * 1024 + ch; return (f32x2){st[0], st[1]}; }
    return (f32x2){0.f, 0.f};
}
__device__ __forceinline__ void conv_unit(const Frame& F, const ConvSeg& sg) {
    const int ch = 2 * F.tid;
    LAS float* red = (LAS float*)(F.lds + RING_OFF);
    f32x2 w[31];
#pragma unroll
    for (int j = 0; j < 31; ++j) w[j] = *(const f32x2*)(F.fin(I_CW) + (size_t)j * 1024 + ch);
    const f32x2 cb = *(const f32x2*)(F.fin(I_CB) + ch), lg = *(const f32x2*)(F.fin(I_CLG) + ch), lb = *(const f32x2*)(F.fin(I_CLB) + ch);
    bf16* OC = (bf16*)(F.ws + WS_OC);
    for (int q0 = 0; q0 < sg.nrows; q0 += 8) {
        f32x2 acc[8];
#pragma unroll
        for (int o = 0; o < 8; ++o) acc[o] = cb;
#pragma unroll
        for (int ii0 = 0; ii0 < 40; ii0 += 4) {
            f32x2 xs[4];
            int ib = q0 - 30 + ii0; PX_OPAQUE_S(ib);
#pragma unroll
            for (int k = 0; k < 4; ++k) { const int i = ib + k; xs[k] = (ii0 + k < 38 && i < sg.nrows) ? conv_in(F, sg, i, ch) : (f32x2){0.f, 0.f}; }
#pragma unroll
            for (int k = 0; k < 4; ++k)
#pragma unroll
                for (int o = 0; o < 8; ++o) { const int j = ii0 + k - o; if (j >= 0 && j <= 30) acc[o] = acc[o] + w[j] * xs[k]; }
            asm volatile("" ::: "memory");
        }
        LAS float* rp = red + ((q0 >> 3) & 1) * 128;
#pragma unroll
        for (int o = 0; o < 8; ++o) { const float s1 = wave_sum(acc[o][0] + acc[o][1]), s2 = wave_sum(acc[o][0] * acc[o][0] + acc[o][1] * acc[o][1]);
            if (F.lane == 0) { rp[(o * 8 + F.wave) * 2] = s1; rp[(o * 8 + F.wave) * 2 + 1] = s2; } }
        px_block_sync();
#pragma unroll
        for (int o = 0; o < 8; ++o) { if (q0 + o >= sg.nrows) continue;
            float s1 = 0.f, s2 = 0.f;
#pragma unroll
            for (int wv = 0; wv < 8; ++wv) { s1 += rp[(o * 8 + wv) * 2]; s2 += rp[(o * 8 + wv) * 2 + 1]; }
            const float mean = s1 * (1.0f / 1024.f), var = s2 * (1.0f / 1024.f) - mean * mean, rstd = px_rsq(var + EPSN);
            const float y0 = (acc[o][0] - mean) * rstd * lg[0] + lb[0], y1 = (acc[o][1] - mean) * rstd * lg[1] + lb[1];
            *(unsigned*)(OC + (size_t)(sg.r0g + q0 + o) * DM + 1024 + ch) = pk2(siluf_(y0), siluf_(y1)); }
    }
    px_block_sync();
    if (sg.kind == 2) {
        for (int r = 0; r < 26; ++r) *(f32x2*)(F.out + OFF_CS + ((size_t)sg.b * 30 + r) * 1024 + ch) = *(const f32x2*)(F.fin(I_SCONV) + ((size_t)sg.b * 30 + r + 4) * 1024 + ch); }
}
constexpr int CONV_UNITS = NBATCH * 64 + 1 + 8;
__device__ __forceinline__ void conv_phase_unit(const Frame& F, int u) {
    ConvSeg sg;
    if (u < NBATCH * 64) { sg.kind = 0; sg.b = u >> 6; sg.s0 = (u & 63) * 32; sg.r0g = sg.b * SEQ + sg.s0; sg.nrows = 32; }
    else if (u == NBATCH * 64) { sg.kind = 1; sg.b = 0; sg.s0 = 0; sg.r0g = META0; sg.nrows = NMETA; }
    else { sg.kind = 2; sg.b = u - NBATCH * 64 - 1; sg.s0 = 0; sg.r0g = SMP0 + 4 * sg.b; sg.nrows = 4; }
    conv_unit(F, sg);
}
constexpr int SSM_HROW = 272, SSM_HWAVE = 32 * SSM_HROW;
__device__ __forceinline__ void ssm_run(const Frame& F, int g, int r0g, int nsteps, f32x2& h, bool do_y) {
    const int lane = F.lane, l31 = lane & 31, hh = lane >> 5, l15 = lane & 15, l4 = lane >> 4;
    const bf16* U = (const bf16*)(F.ws + WS_U); bf16* Y = (bf16*)(F.ws + WS_Y);
    const bf16* BBT = (const bf16*)(F.ws + WS_PAR + PAR_BBT) + (size_t)g * 2048; const bf16* CCT = (const bf16*)(F.ws + WS_PAR + PAR_CCT) + (size_t)g * 2048;
    bf16x8 bbf[4], ccf[4];
#pragma unroll
    for (int cb = 0; cb < 4; ++cb) { bbf[cb] = *(const bf16x8*)(BBT + ((cb * 32 + l31) * 16 + 8 * hh)); ccf[cb] = *(const bf16x8*)(CCT + l15 * 128 + cb * 32 + 8 * l4); }
    const f32x2 ab = ((const f32x2*)(F.ws + WS_PAR + PAR_ABAR))[g * 64 + lane];
    const float dg = F.fin(I_SD)[g * 16 + l15];
    LAS unsigned char* Hl = F.lds + RING_OFF + F.wave * SSM_HWAVE;
    float hr = h[0], hi = h[1];
    for (int t0 = 0; t0 < nsteps; t0 += 32) {
        bf16x8 af = (bf16x8){0, 0, 0, 0, 0, 0, 0, 0};
        if (t0 + l31 < nsteps) af = *(const bf16x8*)(U + (size_t)(r0g + t0 + l31) * DM + 16 * g + 8 * hh);
        const f32x16 z = {0.f, 0.f, 0.f, 0.f, 0.f, 0.f, 0.f, 0.f, 0.f, 0.f, 0.f, 0.f, 0.f, 0.f, 0.f, 0.f};
        const f32x16 d0 = px_mfma32(af, bbf[0], z), d1 = px_mfma32(af, bbf[1], z), d2 = px_mfma32(af, bbf[2], z), d3 = px_mfma32(af, bbf[3], z);
        float re_e[16], re_o[16], im_e[16], im_o[16];
#pragma unroll
        for (int rg = 0; rg < 16; ++rg) { px_swap32(d0[rg], d2[rg], re_e[rg], re_o[rg]); px_swap32(d1[rg], d3[rg], im_e[rg], im_o[rg]); }
#pragma unroll
        for (int q = 0; q < 4; ++q)
#pragma unroll
            for (int s = 0; s < 2; ++s)
#pragma unroll
                for (int i = 0; i < 4; ++i) { const int rg = 4 * q + i, t = 8 * q + 4 * s + i;
                    const float br = s ? re_o[rg] : re_e[rg], bi = s ? im_o[rg] : im_e[rg];
                    const float nr = ab[0] * hr - ab[1] * hi + br, ni = ab[0] * hi + ab[1] * hr + bi;
                    if (t0 + t < nsteps) { hr = nr; hi = ni; }
                    if (do_y) *(LAS unsigned*)(Hl + t * SSM_HROW + 4 * lane) = pk2(nr, ni); }
        if (do_y) {
            px_wave_sync();
#pragma unroll
            for (int mb = 0; mb < 2; ++mb) {
                f32x4 ya = {0.f, 0.f, 0.f, 0.f};
#pragma unroll
                for (int ks = 0; ks < 4; ++ks) { const bf16x8 hf = *(const LAS bf16x8*)(Hl + (16 * mb + l15) * SSM_HROW + (ks * 32 + 8 * l4) * 2); ya = px_mfma16(hf, ccf[ks], ya); }
#pragma unroll
                for (int r = 0; r < 4; ++r) { const int t = 16 * mb + 4 * l4 + r;
                    if (t0 + t < nsteps) { const size_t off = (size_t)(r0g + t0 + t) * DM + 16 * g + l15; const float y = ya[r] + dg * bf2f(U[off]); Y[off] = (bf16)f2bf(gelu_tanh(y)); } }
            }
            px_wave_sync();
        }
    }
    h[0] = hr; h[1] = hi;
}
__device__ __forceinline__ f32x2 cmul(f32x2 a, f32x2 b) { return (f32x2){a[0] * b[0] - a[1] * b[1], a[0] * b[1] + a[1] * b[0]}; }
constexpr int S1_MAIN = NBATCH * 7 * 16, S1_UNITS = S1_MAIN + 16 + 8 * 16, S2_UNITS = NBATCH * 8 * 16;
__device__ __forceinline__ void ssm_pass1_unit(const Frame& F, int bu) {
    f32x2* E = (f32x2*)(F.ws + WS_SSME); f32x2* EM = E + (size_t)NBATCH * 8 * 128 * 64;
    if (bu < S1_MAIN) { const int g = (bu & 15) * 8 + F.wave, k = (bu >> 4) % 7, b = (bu >> 4) / 7; f32x2 h = {0.f, 0.f};
        ssm_run(F, g, b * SEQ + 256 * k, 256, h, false); E[((size_t)(b * 8 + k) * 128 + g) * 64 + F.lane] = h; }
    else if (bu < S1_MAIN + 16) { const int g = (bu - S1_MAIN) * 8 + F.wave; f32x2 h = {0.f, 0.f}; ssm_run(F, g, META0, NMETA, h, true); EM[g * 64 + F.lane] = h; }
    else { const int v = bu - S1_MAIN - 16, bs = v >> 4, g = (v & 15) * 8 + F.wave; const size_t si = ((size_t)bs * 128 + g) * 64 + F.lane;
        f32x2 h = {F.fin(I_SSRE)[si], F.fin(I_SSIM)[si]}; ssm_run(F, g, SMP0 + 4 * bs, 4, h, true); F.out[OFF_SRS + si] = h[0]; F.out[OFF_SIS + si] = h[1]; }
}
__device__ __forceinline__ void ssm_pass2_unit(const Frame& F, int bu) {
    const f32x2* E = (const f32x2*)(F.ws + WS_SSME); const f32x2* EM = E + (size_t)NBATCH * 8 * 128 * 64; const f32x2* PW = (const f32x2*)(F.ws + WS_PAR + PAR_PW);
    const int g = (bu & 15) * 8 + F.wave, k = (bu >> 4) & 7, b = bu >> 7;
    f32x2 h = cmul(PW[(g * 9 + k) * 64 + F.lane], EM[g * 64 + F.lane]);
    for (int j = 0; j < k; ++j) h = h + cmul(PW[(g * 9 + (k - 1 - j)) * 64 + F.lane], E[((size_t)(b * 8 + j) * 128 + g) * 64 + F.lane]);
    ssm_run(F, g, b * SEQ + 256 * k, 256, h, true);
    if (k == 7) { const size_t si = ((size_t)b * 128 + g) * 64 + F.lane; F.out[OFF_SRP + si] = h[0]; F.out[OFF_SIP + si] = h[1]; }
}

__device__ __forceinline__ void meta_attn(const Frame& F) {
    const int h = F.wave, lane = F.lane, j = lane & 15, dp = lane >> 4;
    const bf16* Qb = (const bf16*)(F.ws + WS_Q); const bf16* Kb = (const bf16*)(F.ws + WS_KB); const bf16* Vb = (const bf16*)(F.ws + WS_VB); bf16* OC = (bf16*)(F.ws + WS_OC);
    const float lam = ((const float*)(F.ws + WS_PAR + PAR_LAM))[0], sl2 = exp2f(-(float)(h + 1)) * 1.4426950408889634f;
    const f32x2 sg = *(const f32x2*)(F.fin(I_SUBG) + 2 * lane);
    for (int q = 0; q < NMETA; ++q) {
        float on[2][2];
#pragma unroll
        for (int m = 0; m < 2; ++m) {
            const bf16* qp = Qb + (size_t)(META0 + q) * 1024 + (2 * h + m) * 64 + 16 * dp; const bf16* kp = Kb + (size_t)j * 1024 + (2 * h + m) * 64 + 16 * dp;
            float s = 0.f;
#pragma unroll
            for (int e = 0; e < 16; ++e) s += bf2f(qp[e]) * bf2f(kp[e]);
            s += px_shfl_xor(s, 16); s += px_shfl_xor(s, 32);
            s = (j <= q) ? s + sl2 * (float)j : -INFINITY;
            float mx = s;
#pragma unroll
            for (int o = 1; o < 16; o <<= 1) mx = fmaxf(mx, px_shfl_xor(mx, o));
            const float p = px_exp2(s - mx); float l = p;
#pragma unroll
            for (int o = 1; o < 16; o <<= 1) l += px_shfl_xor(l, o);
            float o0 = 0.f, o1 = 0.f;
#pragma unroll
            for (int jj = 0; jj < 16; ++jj) { const float pj = px_shfl(p, jj); const unsigned vv = *(const unsigned*)(Vb + (size_t)jj * 1024 + h * 128 + 2 * lane); o0 += pj * bf_lo(vv); o1 += pj * bf_hi(vv); }
            const float il = 1.0f / l; on[m][0] = o0 * il; on[m][1] = o1 * il;
        }
        const float c0 = on[0][0] - lam * on[1][0], c1 = on[0][1] - lam * on[1][1];
        const float rstd = px_rsq(wave_sum(c0 * c0 + c1 * c1) * (1.0f / 128.f) + EPSN) * 0.8f;
        *(unsigned*)(OC + (size_t)(META0 + q) * DM + h * 128 + 2 * lane) = pk2(c0 * rstd * sg[0], c1 * rstd * sg[1]);
    }
}
__device__ __forceinline__ void combine_row(const Frame& F, int row) {
    const bf16* O2 = (const bf16*)(F.ws + WS_O2) + (size_t)row * 2048; bf16* OC = (bf16*)(F.ws + WS_OC) + (size_t)row * DM;
    const int h = F.lane >> 3, sub = F.lane & 7; const float lam = ((const float*)(F.ws + WS_PAR + PAR_LAM))[0];
    const u32x4 a0 = *(const u32x4*)(O2 + (2 * h) * 128 + 16 * sub), a1 = *(const u32x4*)(O2 + (2 * h) * 128 + 16 * sub + 8);
    const u32x4 b0 = *(const u32x4*)(O2 + (2 * h + 1) * 128 + 16 * sub), b1 = *(const u32x4*)(O2 + (2 * h + 1) * 128 + 16 * sub + 8);
    float c[16]; float ss = 0.f;
#pragma unroll
    for (int i = 0; i < 4; ++i) { c[2 * i] = bf_lo(a0[i]) - lam * bf_lo(b0[i]); c[2 * i + 1] = bf_hi(a0[i]) - lam * bf_hi(b0[i]); c[8 + 2 * i] = bf_lo(a1[i]) - lam * bf_lo(b1[i]); c[8 + 2 * i + 1] = bf_hi(a1[i]) - lam * bf_hi(b1[i]); }
#pragma unroll
    for (int i = 0; i < 16; ++i) ss += c[i] * c[i];
    ss += px_shfl_xor(ss, 1); ss += px_shfl_xor(ss, 2); ss += px_shfl_xor(ss, 4);
    const float rstd = px_rsq(ss * (1.0f / 128.f) + EPSN) * 0.8f; const float* sg = F.fin(I_SUBG) + 16 * sub;
    u32x4 w0, w1;
#pragma unroll
    for (int i = 0; i < 4; ++i) { w0[i] = pk2(c[2 * i] * rstd * sg[2 * i], c[2 * i + 1] * rstd * sg[2 * i + 1]); w1[i] = pk2(c[8 + 2 * i] * rstd * sg[8 + 2 * i], c[8 + 2 * i + 1] * rstd * sg[8 + 2 * i + 1]); }
    *(u32x4*)(OC + h * 128 + 16 * sub) = w0; *(u32x4*)(OC + h * 128 + 16 * sub + 8) = w1;
}

typedef float f32x8 __attribute__((ext_vector_type(8)));
constexpr int DEC_UNITS = 8 * 8 * NSD, DEC_PPS = (PASTLEN / 16) / NSD, DEC_PPW = DEC_PPS / 8;
constexpr int DLDS_P = 0, DLDS_MRG = 8 * 64 * 2, DMRG_REC = 4 + 128;
static_assert(DEC_PPW <= 64 && DEC_PPW >= 1, "decode split");
__device__ __forceinline__ float u2f(unsigned u) { return __builtin_bit_cast(float, u); }
__device__ __forceinline__ u32x4 tobf8(u32x4 a, u32x4 b) { u32x4 w; w.x = px_cvtpk(u2f(a.x), u2f(a.y)); w.y = px_cvtpk(u2f(a.z), u2f(a.w)); w.z = px_cvtpk(u2f(b.x), u2f(b.y)); w.w = px_cvtpk(u2f(b.z), u2f(b.w)); return w; }
__device__ __forceinline__ float xrow16_max(float x) { float a, b; px_swap16(x, x, a, b); x = fmaxf(a, b); px_swap32(x, x, a, b); return fmaxf(a, b); }
__device__ __forceinline__ float xrow16_sum(float x) { float a, b; px_swap16(x, x, a, b); x = a + b; px_swap32(x, x, a, b); return a + b; }
__device__ __forceinline__ void decode_unit(const Frame& F, int u) {
    constexpr int XOR1 = 0xB1, XOR2 = 0x4E, XOR7 = 0x141, XOR8 = 0x128, ROR4 = 0x124;
    const int sp = u % NSD, h = (u / NSD) & 7, b = u / (NSD * 8);
    LAS float* lds = (LAS float*)(F.lds + RING_OFF);
    int lane_ = F.lane; PX_OPAQUE_V(lane_);
    const int lane = lane_, wave = F.wave, r = lane >> 4, c = lane & 15;
    const float sl2 = exp2f(-(float)(h + 1)) * 1.4426950408889634f;
    const float* ck = F.fin(I_CK); const float* cv = F.fin(I_CV); const int* pt = (const int*)F.in[I_PT];
    const bf16* Qb = (const bf16*)(F.ws + WS_Q);
    const int p0 = sp * DEC_PPS;
    int btv = 0;
    if (lane < DEC_PPW) { const int lp = p0 + wave + 8 * lane; btv = pt[b * NPAGE + (lp >> 3)] * 8 + (lp & 7); }
    const int mc = c >> 3;
    u32x4 qpk[4];
#pragma unroll
    for (int t = 0; t < 4; ++t) qpk[t] = *(const u32x4*)(Qb + (size_t)(SMP0 + 4 * b + t) * 1024 + (2 * h + mc) * 64 + 8 * (c & 7));
    const unsigned loffb = (unsigned)(r * 1024 + 8 * c) * 4u;
#define DEC_ISSUE(i_) do { const int phys_ = px_readlane(btv, (i_)); const float* kb_ = ck + (size_t)phys_ * (16 * 1024) + h * 128; const float* vb_ = cv + (size_t)phys_ * (16 * 1024) + h * 128; \
    _Pragma("unroll") for (int t_ = 0; t_ < 4; ++t_) { const unsigned o_ = loffb + (unsigned)t_ * 16384u; \
        Kn[t_][0] = px_bufload16(kb_, o_); Kn[t_][1] = px_bufload16(kb_, o_ + 16u); Vn[t_][0] = px_bufload16(vb_, o_); Vn[t_][1] = px_bufload16(vb_, o_ + 16u); } } while (0)
    u32x4 Kn[4][2], Vn[4][2];
    float m[2], l[2], acc[64];
#pragma unroll
    for (int j = 0; j < 2; ++j) { m[j] = -INFINITY; l[j] = 0.f; }
#pragma unroll
    for (int k = 0; k < 64; ++k) acc[k] = 0.f;
    DEC_ISSUE(0);
    for (int i = 0; i < DEC_PPW; ++i) {
        u32x4 Kc[4], Vc[4];
#pragma unroll
        for (int t = 0; t < 4; ++t) { Kc[t] = tobf8(Kn[t][0], Kn[t][1]); Vc[t] = tobf8(Vn[t][0], Vn[t][1]); }
        const int lp = p0 + wave + 8 * i;
        if (i + 1 < DEC_PPW) DEC_ISSUE(i + 1);
        float x[32];
#pragma unroll
        for (int t = 0; t < 4; ++t)
#pragma unroll
            for (int tq = 0; tq < 4; ++tq) { float d = 0.f;
#pragma unroll
                for (int k = 0; k < 4; ++k) d = px_dot2(Kc[t][k], qpk[tq][k], d);
                x[t * 8 + 2 * tq] = mc ? 0.f : d; x[t * 8 + 2 * tq + 1] = mc ? d : 0.f; }
#define TR_STEP(HALF, CTRL, BIT) _Pragma("unroll") for (int hx = 0; hx < (HALF); ++hx) _Pragma("unroll") for (int j = 0; j < 2; ++j) { \
      const float lo_ = x[hx * 2 + j], hi_ = x[(hx + (HALF)) * 2 + j]; const float t1_ = lo_ + px_dpp<CTRL>(lo_), t2_ = hi_ + px_dpp<CTRL>(hi_); \
      x[hx * 2 + j] = (c & (BIT)) ? t2_ : t1_; }
        TR_STEP(8, XOR8, 8) TR_STEP(4, XOR7, 4) TR_STEP(2, XOR2, 2) TR_STEP(1, XOR1, 1)
#undef TR_STEP
        const float bias = sl2 * (float)(lp * 16 + r + 4 * (c >> 2) - PASTLEN);
        float p[2], alpha[2];
#pragma unroll
        for (int j = 0; j < 2; ++j) {
            const float sc = x[j] + bias;
            float pm = sc; pm = fmaxf(pm, px_dpp<ROR4>(pm)); pm = fmaxf(pm, px_dpp<XOR8>(pm)); pm = xrow16_max(pm);
            const float mn = fmaxf(m[j], pm);
            alpha[j] = px_exp2(m[j] - mn); p[j] = px_exp2(sc - mn);
            l[j] = fmaf(l[j], alpha[j], p[j]); m[j] = mn;
        }
#pragma unroll
        for (int q4 = 0; q4 < 4; ++q4)
#pragma unroll
            for (int j = 0; j < 2; ++j) {
                const float al = q4 == 0 ? px_dpp<0x00>(alpha[j]) : q4 == 1 ? px_dpp<0x55>(alpha[j]) : q4 == 2 ? px_dpp<0xAA>(alpha[j]) : px_dpp<0xFF>(alpha[j]);
#pragma unroll
                for (int k = 0; k < 8; ++k) acc[(q4 * 2 + j) * 8 + k] *= al; }
        LAS float* prow = lds + DLDS_P + (wave * 4 + r) * 32;
#pragma unroll
        for (int j = 0; j < 2; ++j) prow[c * 2 + j] = p[j];
        px_wave_sync();
#pragma unroll
        for (int t = 0; t < 4; ++t) {
            const f32x4 pa = *(const LAS f32x4*)(prow + 8 * t), pb = *(const LAS f32x4*)(prow + 8 * t + 4);
            float vf[8];
#pragma unroll
            for (int k = 0; k < 4; ++k) { vf[2 * k] = bf_lo(Vc[t][k]); vf[2 * k + 1] = bf_hi(Vc[t][k]); }
#pragma unroll
            for (int g = 0; g < 8; ++g) { const float pg_ = g < 4 ? pa[g & 3] : pb[g & 3];
#pragma unroll
                for (int k = 0; k < 8; ++k) acc[g * 8 + k] = fmaf(pg_, vf[k], acc[g * 8 + k]); }
            asm volatile("" ::: "memory"); }
        px_wave_sync();
    }
#undef DEC_ISSUE
    int lane2 = lane; PX_OPAQUE_V(lane2);
    const int r2 = lane2 >> 4, c2 = lane2 & 15;
#pragma unroll
    for (int k = 0; k < 64; ++k) acc[k] = xrow16_sum(acc[k]);
#pragma unroll
    for (int j = 0; j < 2; ++j) { float t = l[j]; t += px_dpp<ROR4>(t); t += px_dpp<XOR8>(t); l[j] = xrow16_sum(t); }
    LAS float* mrg = lds + DLDS_MRG;
    if (r2 == 0) {
#pragma unroll
        for (int g = 0; g < 8; ++g) { LAS float* rec = mrg + (wave * 8 + g) * DMRG_REC;
#pragma unroll
            for (int k = 0; k < 8; k += 4) *(LAS f32x4*)(rec + 4 + 8 * c2 + k) = (f32x4){acc[g * 8 + k], acc[g * 8 + k + 1], acc[g * 8 + k + 2], acc[g * 8 + k + 3]};
            if (c2 == g / 2) { rec[0] = m[g % 2]; rec[1] = l[g % 2]; } } }
    px_block_sync();
    {
        const int g = wave, d0 = 2 * lane2;
        float M = -INFINITY;
#pragma unroll
        for (int w = 0; w < 8; ++w) M = fmaxf(M, mrg[(w * 8 + g) * DMRG_REC]);
        float L = 0.f, o0 = 0.f, o1 = 0.f;
#pragma unroll
        for (int w = 0; w < 8; ++w) { const LAS float* rec = mrg + (w * 8 + g) * DMRG_REC; const float lw = rec[1]; const float wt = px_exp2(rec[0] - M);
            L = fmaf(wt, lw, L); o0 = fmaf(wt, rec[4 + d0], o0); o1 = fmaf(wt, rec[4 + d0 + 1], o1); }
        float* dst = (float*)(F.ws + WS_DEC) + ((size_t)(((b * 8 + h) * NSD + sp) * 8 + g)) * DEC_REC;
        *(f32x2*)(dst + 4 + d0) = (f32x2){o0, o1};
        if (lane2 == 0) *(f32x2*)dst = (f32x2){M, L};
    }
    px_block_sync();
}
__device__ __forceinline__ void decode_combine(const Frame& F, int bh) {
    const int b = bh >> 3, h = bh & 7, lane = F.lane, d0 = 2 * lane;
    const float lam = ((const float*)(F.ws + WS_PAR + PAR_LAM))[0], sl2 = exp2f(-(float)(h + 1)) * 1.4426950408889634f;
    const bf16* Qb = (const bf16*)(F.ws + WS_Q); const float* KS = F.out + OFF_KS; const float* VS = F.out + OFF_VS; bf16* OC = (bf16*)(F.ws + WS_OC);
    const f32x2 sg = *(const f32x2*)(F.fin(I_SUBG) + d0);
    float on[4][2][2];
#pragma unroll
    for (int g = 0; g < 8; ++g) { const int t = g >> 1, m = g & 1;
        const float* rec0 = (const float*)(F.ws + WS_DEC) + ((size_t)(((b * 8 + h) * NSD) * 8 + g)) * DEC_REC;
        float M = -INFINITY;
        for (int s = 0; s < NSD; ++s) M = fmaxf(M, rec0[(size_t)s * 8 * DEC_REC]);
        float sn[4];
        const float qv = bf2f(Qb[(size_t)(SMP0 + 4 * b + t) * 1024 + (2 * h + m) * 64 + lane]);
#pragma unroll
        for (int tp = 0; tp < 4; ++tp) { sn[tp] = -INFINITY; if (tp <= t) { sn[tp] = wave_sum(qv * KS[(size_t)(4 * b + tp) * 1024 + (2 * h + m) * 64 + lane]) + sl2 * (float)tp; M = fmaxf(M, sn[tp]); } }
        float L = 0.f, o0 = 0.f, o1 = 0.f;
        for (int s = 0; s < NSD; ++s) { const float* rec = rec0 + (size_t)s * 8 * DEC_REC; const float w = px_exp2(rec[0] - M); L = fmaf(w, rec[1], L); o0 = fmaf(w, rec[4 + d0], o0); o1 = fmaf(w, rec[4 + d0 + 1], o1); }
#pragma unroll
        for (int tp = 0; tp < 4; ++tp) if (tp <= t) { const float w = px_exp2(sn[tp] - M); const f32x2 vv = *(const f32x2*)(VS + (size_t)(4 * b + tp) * 1024 + h * 128 + d0); L += w; o0 = fmaf(w, vv[0], o0); o1 = fmaf(w, vv[1], o1); }
        const float il = 1.0f / L; on[t][m][0] = o0 * il; on[t][m][1] = o1 * il;
    }
#pragma unroll
    for (int t = 0; t < 4; ++t) { const float c0 = on[t][0][0] - lam * on[t][1][0], c1 = on[t][0][1] - lam * on[t][1][1];
        const float rstd = px_rsq(wave_sum(c0 * c0 + c1 * c1) * (1.0f / 128.f) + EPSN) * 0.8f;
        *(unsigned*)(OC + (size_t)(SMP0 + 4 * b + t) * DM + h * 128 + d0) = pk2(c0 * rstd * sg[0], c1 * rstd * sg[1]); }
}
#ifndef MK_N_LAUNCHES
#define MK_N_LAUNCHES 1
#endif
constexpr int N_PHASES = 18, N_LAUNCHES = MK_N_LAUNCHES;
#ifndef HOST_EMU
__device__ __forceinline__ void attn_main_units(const Frame& F, char* ldsc) {
    const attn_body::bf16* Q = (const attn_body::bf16*)(F.ws + WS_Q); const attn_body::bf16* K = (const attn_body::bf16*)(F.ws + WS_KB);
    const attn_body::bf16* V = (const attn_body::bf16*)(F.ws + WS_VB); attn_body::bf16* O = (attn_body::bf16*)(F.ws + WS_O2);
    for (int idx = F.vcu; idx < 1024; idx += F.G) {
        const int v = idx & 255, i = idx >> 8, combo = v >> 1, dh = combo & 1, hm = (combo >> 1) & 15, b = combo >> 5, ps = v & 1;
        const int qb = ps == 0 ? (i == 0 ? 0 : i == 1 ? 7 : i == 2 ? 1 : 6) : (i == 0 ? 2 : i == 1 ? 5 : i == 2 ? 3 : 4);
        const int h = hm >> 1;
        const float sl2 = __builtin_bit_cast(float, __builtin_amdgcn_readfirstlane(__builtin_bit_cast(int, exp2f(-(float)(h + 1)) * 1.4426950408889634f)));
        attn_body::attn_unit<8>(b * SEQ + qb * 256, b * KROWS, qb, hm * 64, (2 * h + dh) * 64, hm * 128 + dh * 64, sl2, Q, K, V, O, ldsc);
    }
}
#endif

__global__ void __launch_bounds__(NTHR, 2) mega_fwd(Args args) {
    PX_DYN_LDS(lds);
    Frame F;
    F.lds = (LAS unsigned char*)lds;
    F.tid = threadIdx.x; F.lane = F.tid & 63; F.wave = px_rfl(F.tid >> 6);
    F.G = gridDim.x; { const int bx = blockIdx.x; F.vcu = (F.G % 8 == 0) ? (bx % 8) * (F.G / 8) + bx / 8 : bx; }
    F.in = args.in; F.out = args.out; F.ws = args.ws;
    const int lo = args.ph_lo, hi = args.ph_hi;
#ifndef HOST_EMU
    volatile LAS unsigned* MISC = (volatile LAS unsigned*)(F.lds + MISC_OFF);
    for (int u = F.tid; u < (LDS_BYTES - LDSCTL_OFF) / 4; u += NTHR) ((LAS unsigned*)(F.lds + LDSCTL_OFF))[u] = 0u;
    __syncthreads();
    XcdBarrier bar; bar.bar = (unsigned*)(F.ws + WS_CTL) + CW_BAR; bar.x = 0; bar.st = nullptr;
    if (N_LAUNCHES == 1) bar = xcd_barrier_post((unsigned*)(F.ws + WS_CTL) + CW_BAR, MISC + 8);
#define GRID_BAR() do { if (N_LAUNCHES == 1) xcd_barrier(bar); } while (0)
#else
#define GRID_BAR() do { } while (0)
#endif
#ifdef PH_MASK
#define IN(k) ((((PH_MASK) >> (k)) & 1) && lo <= (k) && (k) < hi)
#else
#define IN(k) (lo <= (k) && (k) < hi)
#endif
#define SEAM(k) do { if (IN(k) && IN((k) + 1)) GRID_BAR(); } while (0)
#define FRESH() do { F.lane = px_lane_id(); F.tid = F.wave * 64 + F.lane; } while (0)
    const float* RS = (const float*)(F.ws + WS_RS);
    bf16* XB = (bf16*)(F.ws + WS_XB); float* MB = (float*)(F.ws + WS_M); bf16* HID = (bf16*)(F.ws + WS_HID); bf16* OC = (bf16*)(F.ws + WS_OC);

    if (IN(0)) { FRESH(); p0_prologue(F); } SEAM(0);
    if (IN(1)) { FRESH();
        pg8::Gemm g{XB, (const bf16*)(F.ws + WS_WIN0), MP, NIN0, DM}; pg8::StaticOrder S; S.init(MP, NIN0, F.G, (int)blockIdx.x);
        pg8::EpiIn0 E{RS, (bf16*)(F.ws + WS_Q), (bf16*)(F.ws + WS_KB), (bf16*)(F.ws + WS_VB), (bf16*)(F.ws + WS_G), F.out};
        pg8::gemm_phase<pg8::EpiIn0, pg8::StaticOrder, true, true>(F.lds + RING_OFF, g, S, E); } SEAM(1);
    if (IN(2)) { FRESH();
#ifndef PH2_MASK
#define PH2_MASK 15
#endif
#ifndef HOST_EMU
        if (PH2_MASK & 1) attn_main_units(F, (char*)lds + RING_OFF);
#endif
        FRESH();
        if (PH2_MASK & 2) for (int u = F.vcu; u < DEC_UNITS; u += F.G) if (EMU_UNIT_OK(u)) decode_unit(F, u);
        FRESH();
        if (PH2_MASK & 4) for (int u = F.vcu; u < CONV_UNITS; u += F.G) if (EMU_UNIT_OK(1000 + u)) conv_phase_unit(F, u);
        FRESH();
        if (PH2_MASK & 8) if (F.vcu == 255 % F.G && EMU_UNIT_OK(2000)) meta_attn(F);
    } SEAM(2);
    if (IN(3)) { FRESH();
        const int gw = F.vcu * NWAVES + F.wave, NGW = F.G * NWAVES;
        for (int row = gw; row < MAIN; row += NGW) if (EMU_UNIT_OK(row)) combine_row(F, row);
        for (int bh = gw; bh < 64; bh += NGW) if (EMU_UNIT_OK(10000 + bh)) decode_combine(F, bh);
    } SEAM(3);
    if (IN(4)) { FRESH();
        pg8::Gemm g{OC, (const bf16*)(F.ws + WS_WOUT0), MP, DM, DM}; pg8::StaticOrder S; S.init(MP, DM, F.G, (int)blockIdx.x);
        pg8::EpiF32 E{MB, DM}; pg8::gemm_phase<pg8::EpiF32, pg8::StaticOrder, true, true>(F.lds + RING_OFF, g, S, E); } SEAM(4);
    if (IN(5)) { FRESH(); resid_phase(F, F.fin(I_NMPOST), true, false); } SEAM(5);
    if (IN(6)) { FRESH();
        pg8::Gemm g{XB, (const bf16*)(F.ws + WS_WGU0), MP, NGU, DM}; pg8::StaticOrder S; S.init(MP, NGU, F.G, (int)blockIdx.x);
        pg8::EpiGU E{RS, HID}; pg8::gemm_phase<pg8::EpiGU, pg8::StaticOrder, true, true>(F.lds + RING_OFF, g, S, E); } SEAM(6);
    if (IN(7)) { FRESH();
        pg8::Gemm g{HID, (const bf16*)(F.ws + WS_WD0), MP, DM, DFF}; pg8::StaticOrder S; S.init(MP, DM, F.G, (int)blockIdx.x);
        pg8::EpiF32 E{MB, DM}; pg8::gemm_phase<pg8::EpiF32, pg8::StaticOrder, true, true>(F.lds + RING_OFF, g, S, E); } SEAM(7);
    if (IN(8)) { FRESH(); resid_phase(F, F.fin(I_NFPOST), false, false); } SEAM(8);
    if (IN(9)) { FRESH();
        pg8::Gemm g{XB, (const bf16*)(F.ws + WS_WIN1), MP, DM, DM}; pg8::StaticOrder S; S.init(MP, DM, F.G, (int)blockIdx.x);
        pg8::EpiU E{RS, (bf16*)(F.ws + WS_U)}; pg8::gemm_phase<pg8::EpiU, pg8::StaticOrder, true, true>(F.lds + RING_OFF, g, S, E); } SEAM(9);
    if (IN(10)) { FRESH(); for (int u = F.vcu; u < S1_UNITS; u += F.G) if (EMU_UNIT_OK(u)) ssm_pass1_unit(F, u); } SEAM(10);
    if (IN(11)) { FRESH(); for (int u = F.vcu; u < S2_UNITS; u += F.G) if (EMU_UNIT_OK(u)) ssm_pass2_unit(F, u); } SEAM(11);
    if (IN(12)) { FRESH();
        pg8::Gemm g{(const bf16*)(F.ws + WS_Y), (const bf16*)(F.ws + WS_WGLU), MP, DM, DM}; pg8::StaticOrder S; S.init(MP, DM, F.G, (int)blockIdx.x);
        pg8::EpiGlu E{(const bf16*)(F.ws + WS_Y), (bf16*)(F.ws + WS_Y2)}; pg8::gemm_phase<pg8::EpiGlu, pg8::StaticOrder, true, true>(F.lds + RING_OFF, g, S, E); } SEAM(12);
    if (IN(13)) { FRESH();
        pg8::Gemm g{(const bf16*)(F.ws + WS_Y2), (const bf16*)(F.ws + WS_WOUT1), MP, DM, DM}; pg8::StaticOrder S; S.init(MP, DM, F.G, (int)blockIdx.x);
        pg8::EpiF32 E{MB, DM}; pg8::gemm_phase<pg8::EpiF32, pg8::StaticOrder, true, true>(F.lds + RING_OFF, g, S, E); } SEAM(13);
    if (IN(14)) { FRESH(); resid_phase(F, F.fin(I_NMPOST) + DM, false, false); } SEAM(14);
    if (IN(15)) { FRESH();
        pg8::Gemm g{XB, (const bf16*)(F.ws + WS_WGU1), MP, NGU, DM}; pg8::StaticOrder S; S.init(MP, NGU, F.G, (int)blockIdx.x);
        pg8::EpiGU E{RS, HID}; pg8::gemm_phase<pg8::EpiGU, pg8::StaticOrder, true, true>(F.lds + RING_OFF, g, S, E); } SEAM(15);
    if (IN(16)) { FRESH();
        pg8::Gemm g{HID, (const bf16*)(F.ws + WS_WD1), MP, DM, DFF}; pg8::StaticOrder S; S.init(MP, DM, F.G, (int)blockIdx.x);
        pg8::EpiF32 E{MB, DM}; pg8::gemm_phase<pg8::EpiF32, pg8::StaticOrder, true, true>(F.lds + RING_OFF, g, S, E); } SEAM(16);
    if (IN(17)) { FRESH(); resid_phase(F, F.fin(I_NFPOST) + DM, false, true); }
#undef IN
#undef SEAM
#undef FRESH
#undef GRID_BAR
}

#ifndef HOST_EMU
extern "C" void kernel_launch(void* const* d_in, const int* in_sizes, int n_in, void* d_out, int out_size, void* d_ws, size_t ws_size, hipStream_t stream) {
    static int grid = 0;
    if (grid == 0) {
        if (n_in != N_IN || (size_t)out_size != OUT_TOTAL || ws_size < WS_END) { fprintf(stderr, "kernel_launch: unexpected problem (n_in %d, out %d, ws %zu)\n", n_in, out_size, ws_size); grid = -1; return; }
        int dev = 0, cus = 0, per_cu = 0;
        if (hipGetDevice(&dev) != hipSuccess || hipDeviceGetAttribute(&cus, hipDeviceAttributeMultiprocessorCount, dev) != hipSuccess) { grid = -1; return; }
        if (hipFuncSetAttribute((const void*)mega_fwd, hipFuncAttributeMaxDynamicSharedMemorySize, LDS_BYTES) != hipSuccess) { fprintf(stderr, "kernel_launch: hipFuncSetAttribute failed\n"); grid = -1; return; }
        if (hipOccupancyMaxActiveBlocksPerMultiprocessor(&per_cu, (const void*)mega_fwd, NTHR, LDS_BYTES) != hipSuccess || per_cu < 1) { fprintf(stderr, "kernel_launch: occupancy query says %d\n", per_cu); }
        (void)hipGetLastError();
        grid = cus;
    }
    if (grid < 0) return;
    if (hipMemsetAsync((char*)d_ws + WS_CTL, 0, CTL_ZERO_BYTES, stream) != hipSuccess) return;
    Args a{};
    for (int i = 0; i < N_IN; ++i) a.in[i] = d_in[i];
    a.out = (float*)d_out; a.ws = (unsigned char*)d_ws;
    for (int li = 0; li < N_LAUNCHES; ++li) {
        a.ph_lo = (N_LAUNCHES == 1) ? 0 : li; a.ph_hi = (N_LAUNCHES == 1) ? N_PHASES : li + 1;
        hipLaunchKernelGGL(mega_fwd, dim3(grid), dim3(NTHR), LDS_BYTES, stream, a);
        const hipError_t le = hipPeekAtLastError();
        if (le != hipSuccess) { fprintf(stderr, "kernel_launch: launch %d failed: %s\n", li, hipGetErrorName(le)); break; }
    }
}
#endif
```

```cpp
#ifndef HOST_EMU
#include <hip/hip_runtime.h>
#include <cstdio>
#include <cstdint>
#include <cmath>
#define LAS __attribute__((address_space(3)))
#define GAS __attribute__((address_space(1)))
typedef short bf16x8 __attribute__((ext_vector_type(8)));
typedef float f32x4 __attribute__((ext_vector_type(4)));
typedef float f32x2 __attribute__((ext_vector_type(2)));
typedef float f32x16 __attribute__((ext_vector_type(16)));
typedef unsigned u32x4 __attribute__((ext_vector_type(4)));
typedef unsigned u32x2 __attribute__((ext_vector_type(2)));
__device__ __forceinline__ float px_shfl_xor(float v, int m) { return __shfl_xor(v, m); }
__device__ __forceinline__ float px_shfl(float v, int src) { return __shfl(v, src); }
__device__ __forceinline__ int px_shfl_i(int v, int src) { return __shfl(v, src); }
__device__ __forceinline__ int px_readlane(int v, int src) { return __builtin_amdgcn_readlane(v, src); }
__device__ __forceinline__ int px_rfl(int v) { return __builtin_amdgcn_readfirstlane(v); }
__device__ __forceinline__ void px_wave_sync() { asm volatile("s_waitcnt lgkmcnt(0)" ::: "memory"); __builtin_amdgcn_wave_barrier(); }
__device__ __forceinline__ void px_block_sync() { __syncthreads(); }
__device__ __forceinline__ float px_exp2(float x) { return __builtin_amdgcn_exp2f(x); }
__device__ __forceinline__ float px_rcp(float x) { return __builtin_amdgcn_rcpf(x); }
__device__ __forceinline__ float px_rsq(float x) { return 1.0f / sqrtf(x); }
__device__ __forceinline__ void px_swap32(float a, float b, float& r0, float& r1) {
    auto rr = __builtin_amdgcn_permlane32_swap(__float_as_uint(a), __float_as_uint(b), false, false); r0 = __uint_as_float(rr[0]); r1 = __uint_as_float(rr[1]); }
__device__ __forceinline__ void px_swap16(float a, float b, float& r0, float& r1) {
    auto rr = __builtin_amdgcn_permlane16_swap(__float_as_uint(a), __float_as_uint(b), false, false); r0 = __uint_as_float(rr[0]); r1 = __uint_as_float(rr[1]); }
template <int CTRL> __device__ __forceinline__ float px_dpp(float x) { return __builtin_bit_cast(float, __builtin_amdgcn_mov_dpp(__builtin_bit_cast(int, x), CTRL, 0xf, 0xf, true)); }
__device__ __forceinline__ f32x4 px_mfma16(bf16x8 a, bf16x8 b, f32x4 c) { return __builtin_amdgcn_mfma_f32_16x16x32_bf16(a, b, c, 0, 0, 0); }
__device__ __forceinline__ f32x16 px_mfma32(bf16x8 a, bf16x8 b, f32x16 c) { return __builtin_amdgcn_mfma_f32_32x32x16_bf16(a, b, c, 0, 0, 0); }
typedef __bf16 px_bf16x2 __attribute__((ext_vector_type(2)));
__device__ __forceinline__ float px_dot2(unsigned k, unsigned q, float acc) { return __builtin_amdgcn_fdot2_f32_bf16(__builtin_bit_cast(px_bf16x2, k), __builtin_bit_cast(px_bf16x2, q), acc, false); }
template <class T> __device__ __forceinline__ T px_ntload(const T* p) { return __builtin_nontemporal_load(p); }
__device__ __forceinline__ u32x4 px_bufload16(const void* ubase, unsigned voff) {
    const __amdgpu_buffer_rsrc_t rs = __builtin_amdgcn_make_buffer_rsrc((void*)ubase, (short)0, 0x20000000, 0x00020000);
    return __builtin_amdgcn_raw_buffer_load_b128(rs, voff, 0, 2); }
#define PX_DYN_LDS(name) extern __shared__ __attribute__((aligned(16))) unsigned char name[]
__device__ __forceinline__ unsigned px_atomic_add(unsigned* p, unsigned v) { return __hip_atomic_fetch_add(p, v, __ATOMIC_RELAXED, __HIP_MEMORY_SCOPE_AGENT); }
__device__ __forceinline__ unsigned px_cvtpk(float lo, float hi) { f32x2 v = {lo, hi}; px_bf16x2 b = __builtin_convertvector(v, px_bf16x2); return __builtin_bit_cast(unsigned, b); }
#define EMU_UNIT_OK(u) true
#define PX_OPAQUE_S(x) asm volatile("" : "+s"(x))
#define PX_OPAQUE_V(x) asm volatile("" : "+v"(x))
__device__ __forceinline__ int px_lane_id() { int l; asm volatile("v_mbcnt_lo_u32_b32 %0, -1, 0\n\tv_mbcnt_hi_u32_b32 %0, -1, %0" : "=v"(l)); return l; }
#else
#define PX_OPAQUE_S(x) asm volatile("" : "+r"(x))
#define PX_OPAQUE_V(x) asm volatile("" : "+r"(x))
static inline u32x4 px_bufload16(const void* ubase, unsigned voff) { return *(const u32x4*)((const char*)ubase + voff); }
static inline int px_lane_id() { return g_cur->tid & 63; }
static inline unsigned px_cvtpk(float lo, float hi);
#define EMU_UNIT_OK(u) ((u) >= emu_unit_lo && (u) < emu_unit_hi)
#endif

typedef unsigned short bf16;
__device__ __forceinline__ unsigned f2bf(float f) { unsigned u = __builtin_bit_cast(unsigned, f); return (u + 0x7fffu + ((u >> 16) & 1u)) >> 16; }
__device__ __forceinline__ unsigned pk2(float lo, float hi) { return f2bf(lo) | (f2bf(hi) << 16); }
#ifdef HOST_EMU
static inline unsigned px_cvtpk(float lo, float hi) { return pk2(lo, hi); }
#endif
__device__ __forceinline__ float bf_lo(unsigned w) { return __builtin_bit_cast(float, w << 16); }
__device__ __forceinline__ float bf_hi(unsigned w) { return __builtin_bit_cast(float, w & 0xffff0000u); }
__device__ __forceinline__ float bf2f(bf16 b) { return __builtin_bit_cast(float, (unsigned)b << 16); }
__device__ __forceinline__ float sigmoidf_(float x) { return px_rcp(1.0f + px_exp2(-1.4426950408889634f * x)); }
__device__ __forceinline__ float siluf_(float x) { return x * sigmoidf_(x); }
__device__ __forceinline__ float gelu_tanh(float x) {
    const float u = 1.5957691216057308f * (x + 0.044715f * x * x * x); return x * sigmoidf_(u); }
__device__ __forceinline__ float wave_sum(float v) {
#pragma unroll
    for (int o = 1; o < 64; o <<= 1) v += px_shfl_xor(v, o);
    return v; }
__device__ __forceinline__ float wave_max(float v) {
#pragma unroll
    for (int o = 1; o < 64; o <<= 1) v = fmaxf(v, px_shfl_xor(v, o));
    return v; }

constexpr int DM = 2048, NBATCH = 4, SEQ = 2048, TFULL = 2064, MAIN = 8192, META0 = 8192, NMETA = 16, SMP0 = 8208, NSMP = 32, NREAL = 8240, MP = 8448;
constexpr int DFF = 5632, NGU = 2 * DFF, NIN0 = 5120, TPREF = 128, KROWS = TPREF + SEQ;
constexpr int NPAGE = 128, PAGE_TOK = 128, PASTLEN = 16384;
constexpr float EPSN = 1e-6f;
constexpr float QSCALE = 0.125f * 1.4426950408889634f;
constexpr size_t OFF_YP = 0, OFF_YS = OFF_YP + (size_t)NBATCH * SEQ * DM, OFF_KP = OFF_YS + (size_t)NSMP * DM, OFF_VP = OFF_KP + (size_t)NBATCH * TFULL * 1024,
                 OFF_KS = OFF_VP + (size_t)NBATCH * TFULL * 1024, OFF_VS = OFF_KS + (size_t)NSMP * 1024, OFF_CP = OFF_VS + (size_t)NSMP * 1024, OFF_CS = OFF_CP + (size_t)NBATCH * 30 * 1024,
                 OFF_SRP = OFF_CS + (size_t)8 * 30 * 1024, OFF_SIP = OFF_SRP + (size_t)NBATCH * 128 * 64, OFF_SRS = OFF_SIP + (size_t)NBATCH * 128 * 64, OFF_SIS = OFF_SRS + (size_t)8 * 128 * 64,
                 OUT_TOTAL = OFF_SIS + (size_t)8 * 128 * 64;
enum { I_XP = 0, I_XS, I_CK, I_CV, I_SCONV, I_SSRE, I_SSIM, I_PT, I_META, I_NMPRE, I_NMPOST, I_NFPRE, I_NFPOST, I_WIN0, I_LQ, I_LK, I_SUBG, I_CW, I_CB, I_CLG, I_CLB, I_WOUT0,
       I_WIN1, I_ARE, I_AIM, I_BRE, I_BIM, I_CRE, I_CIM, I_SD, I_LDT, I_WGLU, I_WOUT1, I_WG, I_WU, I_WD, N_IN };
constexpr size_t MiB = 1u << 20;
constexpr size_t WS_CTL = 0, CTL_ZERO_BYTES = 1 * MiB;
constexpr size_t WS_PAR = 1 * MiB;
constexpr size_t PAR_LAM = 0, PAR_ABAR = 4096, PAR_PW = 131072, PAR_BBT = 1 * MiB, PAR_CCT = 2 * MiB;
constexpr size_t WS_WIN0 = 16 * MiB, WS_WOUT0 = 36 * MiB, WS_WGU0 = 44 * MiB, WS_WD0 = 88 * MiB, WS_WIN1 = 110 * MiB, WS_WGLU = 118 * MiB, WS_WOUT1 = 126 * MiB, WS_WGU1 = 134 * MiB, WS_WD1 = 178 * MiB;
constexpr size_t WS_XB = 200 * MiB, WS_RS = 234 * MiB, WS_XX = 235 * MiB, WS_Q = 238 * MiB, WS_KB = 256 * MiB, WS_VB = 274 * MiB, WS_G = 292 * MiB, WS_O2 = 310 * MiB, WS_OC = 342 * MiB;
constexpr size_t WS_M = 376 * MiB, WS_HID = 442 * MiB, WS_U = 534 * MiB, WS_Y = 568 * MiB, WS_Y2 = 602 * MiB, WS_SSME = 636 * MiB, WS_DEC = 640 * MiB, WS_END = 672 * MiB;
constexpr int NSD = 4;
constexpr int DEC_REC = 132;
constexpr int CW_TMO = 0, CW_CODE = 1, CW_BAR = 4096;

namespace pg8 {
#ifndef HOST_EMU
#define PG8_LAS __attribute__((address_space(3)))
#else
#define PG8_LAS
#endif
typedef unsigned short bf16_t;
typedef short bf16x8 __attribute__((ext_vector_type(8)));
typedef float f32x4 __attribute__((ext_vector_type(4)));
typedef unsigned u32x4 __attribute__((ext_vector_type(4)));
constexpr int BM = 256, BK = 64, HALF = 128, HTB = HALF * BK * 2  , STAGE_BYTES = 8 * HTB, NXCD = 8, WGM = 8;

__host__ __device__ __forceinline__ int lds_byte(int r, int c) { const int st = (r >> 4) * 2 + (c >> 5), rr = r & 15, cc = c & 31, ob = rr * 64 + cc * 2; return st * 1024 + (ob ^ (((ob >> 9) & 1) << 5)); }
__host__ __device__ __forceinline__ void stage_rc(int b, int& R, int& C) { const int st = b / 1024, sb = b % 1024, swz = sb ^ (((sb >> 9) & 1) << 5); R = (st >> 1) * 16 + swz / 64; C = (st & 1) * 32 + (swz % 64) / 2; }
__host__ __device__ __forceinline__ int perm32(int rho) { const int n = rho >> 4, i = rho & 15; return 8 * (i >> 2) + 4 * n + (i & 3); }

struct Unit { int pm, pn; };
struct Gemm { const bf16_t* A; const bf16_t* Bt; int M, N, K; };

struct StaticOrder {
    int nM, nN, nwg, G, c;
    __host__ __device__ void init(int M, int N, int G_, int c_) { nM = M / BM; nN = N / BM; nwg = nM * nN; G = G_; c = c_; }
    __host__ __device__ bool next(int i, Unit& u) const {
        const long L = (long)i * G + c; if (L >= nwg) return false;
        int wgid = (int)L; { const int q = nwg / NXCD, r = nwg % NXCD, xcd = wgid % NXCD, off = wgid / NXCD; wgid = (xcd < r ? xcd * (q + 1) : r * (q + 1) + (xcd - r) * q) + off; }
        const int nig = WGM * nN, gid = wgid / nig, fm = gid * WGM, gsz = (nM - fm) < WGM ? (nM - fm) : WGM;
        u.pm = fm + ((wgid % nig) % gsz); u.pn = (wgid % nig) / gsz; return true;
    }
    __device__ __forceinline__ void a_ready(const Unit&) const {}
    __device__ __forceinline__ void done(const Unit&) const {}
};

}
namespace pg8 {
#ifndef HOST_EMU
__device__ __forceinline__ unsigned cvtpk(float lo, float hi) { unsigned r; asm volatile("v_cvt_pk_bf16_f32 %0, %1, %2" : "=v"(r) : "v"(lo), "v"(hi)); return r; }
#else
inline unsigned cvtpk(float lo, float hi) { return pk2(lo, hi); }
#endif
__device__ __forceinline__ u32x4 pack8(f32x4 a, f32x4 b) { u32x4 w; w.x = cvtpk(a[0], a[1]); w.y = cvtpk(a[2], a[3]); w.z = cvtpk(b[0], b[1]); w.w = cvtpk(b[2], b[3]); return w; }
__device__ __forceinline__ f32x4 sig4(f32x4 x) { f32x4 r; r[0] = sigmoidf_(x[0]); r[1] = sigmoidf_(x[1]); r[2] = sigmoidf_(x[2]); r[3] = sigmoidf_(x[3]); return r; }

struct EpiIn0 {
    static constexpr bool PERM = true, AFTER_DRAIN = false;
    const float* rs; bf16* Qb; bf16* Kb; bf16* Vb; bf16* Gb; float* out;
    __device__ __forceinline__ void operator()(const f32x4 (&acc)[2][2][4][2], const Unit& u, int wr, int wc, int fr, int fq) const {
        const int pn = u.pn, cl = wc * 32 + 8 * fq;
#pragma unroll
        for (int ai = 0; ai < 2; ++ai)
#pragma unroll
            for (int m = 0; m < 4; ++m) {
                const int row = u.pm * BM + ai * HALF + wr * 64 + m * 16 + fr;
                if (row >= NREAL) continue;
                const float r = rs[row];
                if (pn < 12) {
#pragma unroll
                    for (int bj = 0; bj < 2; ++bj) {
                        f32x4 v0 = acc[ai][bj][m][0] * r, v1 = acc[ai][bj][m][1] * r;
                        const int col = 256 * (pn & 3) + 128 * bj + cl;
                        if (pn < 4) { v0 = v0 * QSCALE; v1 = v1 * QSCALE; *(u32x4*)(Qb + (size_t)row * 1024 + col) = pack8(v0, v1); }
                        else {
                            bf16* B = pn < 8 ? Kb : Vb; const u32x4 w = pack8(v0, v1);
                            if (row < MAIN) { const int b = row >> 11, s = row & 2047;
                                *(u32x4*)(B + ((size_t)(b * KROWS + TPREF + s) * 1024 + col)) = w;
                                float* o = out + (pn < 8 ? OFF_KP : OFF_VP) + ((size_t)(b * TFULL + NMETA + s) * 1024 + col); *(f32x4*)o = v0; *(f32x4*)(o + 4) = v1; }
                            else if (row < SMP0) { const int j = row - META0;
#pragma unroll
                                for (int bb = 0; bb < NBATCH; ++bb) { *(u32x4*)(B + ((size_t)(bb * KROWS + j) * 1024 + col)) = w;
                                    float* o = out + (pn < 8 ? OFF_KP : OFF_VP) + ((size_t)(bb * TFULL + j) * 1024 + col); *(f32x4*)o = v0; *(f32x4*)(o + 4) = v1; } }
                            else { const int i = row - SMP0; float* o = out + (pn < 8 ? OFF_KS : OFF_VS) + ((size_t)i * 1024 + col); *(f32x4*)o = v0; *(f32x4*)(o + 4) = v1; }
                        }
                    }
                } else {
                    const int ch = 128 * (pn - 12) + cl;
                    const f32x4 g0 = (acc[ai][0][m][0] * r) * sig4(acc[ai][1][m][0] * r), g1 = (acc[ai][0][m][1] * r) * sig4(acc[ai][1][m][1] * r);
                    *(u32x4*)(Gb + (size_t)row * 1024 + ch) = pack8(g0, g1);
                    if (row < MAIN) { const int s = row & 2047; if (s >= SEQ - 30) { const int b = row >> 11; float* o = out + OFF_CP + ((size_t)(b * 30 + (s - (SEQ - 30))) * 1024 + ch); *(f32x4*)o = g0; *(f32x4*)(o + 4) = g1; } }
                    else if (row >= SMP0) { const int i = row - SMP0; float* o = out + OFF_CS + ((size_t)((i >> 2) * 30 + 26 + (i & 3)) * 1024 + ch); *(f32x4*)o = g0; *(f32x4*)(o + 4) = g1; }
                }
            }
    }
};
struct EpiF32 {
    static constexpr bool PERM = false, AFTER_DRAIN = false;
    float* M; int ldc;
    __device__ __forceinline__ void operator()(const f32x4 (&acc)[2][2][4][2], const Unit& u, int wr, int wc, int fr, int fq) const {
        const int col0 = u.pn * BM + wc * 32 + 4 * fq;
#pragma unroll
        for (int ai = 0; ai < 2; ++ai)
#pragma unroll
            for (int m = 0; m < 4; ++m) { const int row = u.pm * BM + ai * HALF + wr * 64 + m * 16 + fr; if (row >= NREAL) continue;
                float* rp = M + (size_t)row * ldc + col0;
#pragma unroll
                for (int bj = 0; bj < 2; ++bj)
#pragma unroll
                    for (int n = 0; n < 2; ++n) *(f32x4*)(rp + bj * HALF + n * 16) = acc[ai][bj][m][n]; }
    }
};
struct EpiGU {
    static constexpr bool PERM = true, AFTER_DRAIN = false;
    const float* rs; bf16* H;
    __device__ __forceinline__ void operator()(const f32x4 (&acc)[2][2][4][2], const Unit& u, int wr, int wc, int fr, int fq) const {
        const int hc = 128 * u.pn + wc * 32 + 8 * fq;
#pragma unroll
        for (int ai = 0; ai < 2; ++ai)
#pragma unroll
            for (int m = 0; m < 4; ++m) { const int row = u.pm * BM + ai * HALF + wr * 64 + m * 16 + fr; const float r = rs[row];
                f32x4 h[2];
#pragma unroll
                for (int n = 0; n < 2; ++n) { const f32x4 g = acc[ai][0][m][n] * r, up = acc[ai][1][m][n] * r; h[n] = g * sig4(g) * up; }
                *(u32x4*)(H + (size_t)row * DFF + hc) = pack8(h[0], h[1]); }
    }
};
struct EpiU {
    static constexpr bool PERM = true, AFTER_DRAIN = false;
    const float* rs; bf16* U;
    __device__ __forceinline__ void operator()(const f32x4 (&acc)[2][2][4][2], const Unit& u, int wr, int wc, int fr, int fq) const {
#pragma unroll
        for (int ai = 0; ai < 2; ++ai)
#pragma unroll
            for (int m = 0; m < 4; ++m) { const int row = u.pm * BM + ai * HALF + wr * 64 + m * 16 + fr; const float r = rs[row];
#pragma unroll
                for (int bj = 0; bj < 2; ++bj) *(u32x4*)(U + (size_t)row * DM + u.pn * BM + bj * HALF + wc * 32 + 8 * fq) = pack8(acc[ai][bj][m][0] * r, acc[ai][bj][m][1] * r); }
    }
};
struct EpiGlu {
    static constexpr bool PERM = true, AFTER_DRAIN = false;
    const bf16* Y; bf16* Y2;
    __device__ __forceinline__ void operator()(const f32x4 (&acc)[2][2][4][2], const Unit& u, int wr, int wc, int fr, int fq) const {
#pragma unroll
        for (int ai = 0; ai < 2; ++ai)
#pragma unroll
            for (int m = 0; m < 4; ++m) { const int row = u.pm * BM + ai * HALF + wr * 64 + m * 16 + fr;
#pragma unroll
                for (int bj = 0; bj < 2; ++bj) { const size_t off = (size_t)row * DM + u.pn * BM + bj * HALF + wc * 32 + 8 * fq;
                    const u32x4 yv = *(const u32x4*)(Y + off);
                    const f32x4 y0 = {bf_lo(yv.x), bf_hi(yv.x), bf_lo(yv.y), bf_hi(yv.y)}, y1 = {bf_lo(yv.z), bf_hi(yv.z), bf_lo(yv.w), bf_hi(yv.w)};
                    *(u32x4*)(Y2 + off) = pack8(y0 * sig4(acc[ai][bj][m][0]), y1 * sig4(acc[ai][bj][m][1])); } }
    }
};
#ifdef HOST_EMU
template <class Epi, class Sched, bool ALIGN_EPI = false, bool SP2 = false>
inline void gemm_phase(unsigned char* lds, const Gemm g, const Sched& S, const Epi& E) {
    const int tid = threadIdx.x, wid = tid >> 6, lane = tid & 63, wr = wid >> 2, wc = wid & 3, fr = lane & 15, fq = lane >> 4;
    Unit cur;
    for (int ui = 0; S.next(ui, cur); ++ui) {
        const long L = (long)ui * S.G + S.c; if (!EMU_UNIT_OK(L)) continue;
        f32x4 acc[2][2][4][2];
        for (int ai = 0; ai < 2; ++ai) for (int bj = 0; bj < 2; ++bj) for (int m = 0; m < 4; ++m) for (int n = 0; n < 2; ++n) for (int i = 0; i < 4; ++i) {
            const int row = cur.pm * BM + ai * HALF + wr * 64 + m * 16 + fr;
            const int col = cur.pn * BM + bj * HALF + wc * 32 + (Epi::PERM ? 8 * fq + 4 * n + i : 16 * n + 4 * fq + i);
            const bf16_t* a = g.A + (size_t)row * g.K; const bf16_t* b = g.Bt + (size_t)col * g.K; double s = 0.0;
            for (int k = 0; k < g.K; ++k) s += (double)bf2f(a[k]) * (double)bf2f(b[k]);
            acc[ai][bj][m][n][i] = (float)s; }
        E(acc, cur, wr, wc, fr, fq);
    }
}
#endif
}
#ifndef HOST_EMU
namespace pg8 {
template <class Epi, class Sched, bool ALIGN_EPI = false, bool SP2 = false>
__device__ __forceinline__ void gemm_phase(PG8_LAS unsigned char* lds, const Gemm g, const Sched& S, const Epi& E) {
    const int tid = threadIdx.x, wid = __builtin_amdgcn_readfirstlane(tid >> 6), lane = tid & 63, wr = wid >> 2, wc = wid & 3, fr = lane & 15, fq = lane >> 4;
    const int K = g.K, nt = K / BK;
    unsigned voffA[2], voffB[2];
#pragma unroll
    for (int i = 0; i < 2; ++i) { int R, C; stage_rc(tid * 16 + i * 8192, R, C); const int Rb = Epi::PERM ? ((R & ~31) + perm32(R & 31)) : R;
        voffA[i] = (unsigned)(R * K + C) * 2u; voffB[i] = (unsigned)(Rb * K + C) * 2u; }
    const size_t kstep = (size_t)(BK * 2);
    const size_t hstep = (size_t)HALF * K * 2;
    const size_t tstep = 2 * hstep;
    const unsigned ldsw = (unsigned)wid * 1024u;
    const int aoff = lds_byte(wr * 64 + fr, fq * 8), boff = lds_byte(wc * 32 + fr, fq * 8);
#define PG8_SA(b, h) (((b) * 2 + (h)) * HTB)
#define PG8_SB(b, h) ((4 + (b) * 2 + (h)) * HTB)
#define PG8_STAGE(bufoff, gbase, voff) do { _Pragma("unroll") for (int _i = 0; _i < 2; ++_i) \
        __builtin_amdgcn_global_load_lds((const unsigned*)((const char*)(gbase) + (voff)[_i]), (PG8_LAS unsigned*)(lds + (bufoff) + ldsw + _i * 8192), 16, 0, 0); } while (0)
#define PG8_LDA(dst, b, h) do { _Pragma("unroll") for (int m = 0; m < 4; ++m) _Pragma("unroll") for (int k = 0; k < 2; ++k) dst[m][k] = *(const PG8_LAS bf16x8*)(lds + PG8_SA(b, h) + aoff + m * 2048 + k * 1024); } while (0)
#define PG8_LDB(dst, b, h) do { _Pragma("unroll") for (int n = 0; n < 2; ++n) _Pragma("unroll") for (int k = 0; k < 2; ++k) dst[n][k] = *(const PG8_LAS bf16x8*)(lds + PG8_SB(b, h) + boff + n * 2048 + k * 1024); } while (0)
#define PG8_MMA(ai, bj, At, Bt) do { __builtin_amdgcn_s_setprio(1); _Pragma("unroll") for (int m = 0; m < 4; ++m) _Pragma("unroll") for (int n = 0; n < 2; ++n) _Pragma("unroll") for (int k = 0; k < 2; ++k) \
        acc[ai][bj][m][n] = __builtin_amdgcn_mfma_f32_16x16x32_bf16(Bt[n][k], At[m][k], acc[ai][bj][m][n], 0, 0, 0); __builtin_amdgcn_s_setprio(0); } while (0)
#define PG8_WAIT_V(n) asm volatile("s_waitcnt vmcnt(" #n ")" ::: "memory")
#define PG8_WAIT_L(n) asm volatile("s_waitcnt lgkmcnt(" #n ")" ::: "memory")
#define PG8_BAR __builtin_amdgcn_s_barrier()
#define PG8_SCHED __builtin_amdgcn_sched_barrier(0)
    Unit cur, nxt; int ui = 0;
    if (!S.next(0, cur)) return;
    f32x4 acc[2][2][4][2];
#pragma unroll
    for (int a = 0; a < 2; ++a)
#pragma unroll
        for (int b = 0; b < 2; ++b)
#pragma unroll
            for (int m = 0; m < 4; ++m)
#pragma unroll
                for (int n = 0; n < 2; ++n) acc[a][b][m][n] = (f32x4){0.f, 0.f, 0.f, 0.f};
    bf16x8 At[4][2], B0[2][2], B1[2][2];
    const char* cA = (const char*)g.A + (size_t)cur.pm * tstep; const char* cB = (const char*)g.Bt + (size_t)cur.pn * tstep;
    S.a_ready(cur);
    if constexpr (SP2) {
        PG8_STAGE(PG8_SB(0, 0), cB, voffB); PG8_STAGE(PG8_SB(0, 1), cB + hstep, voffB); PG8_STAGE(PG8_SA(0, 0), cA, voffA); PG8_STAGE(PG8_SA(0, 1), cA + hstep, voffA);
        if (wr == 1) PG8_BAR;
        PG8_WAIT_V(2); PG8_BAR;
        PG8_STAGE(PG8_SB(1, 0), cB + kstep, voffB); PG8_STAGE(PG8_SA(1, 0), cA + kstep, voffA); PG8_STAGE(PG8_SB(1, 1), cB + hstep + kstep, voffB);
        PG8_WAIT_V(6); PG8_BAR;
    } else {
        PG8_STAGE(PG8_SB(0, 0), cB, voffB); PG8_STAGE(PG8_SA(0, 0), cA, voffA); PG8_STAGE(PG8_SB(0, 1), cB + hstep, voffB); PG8_STAGE(PG8_SA(0, 1), cA + hstep, voffA);
        if (wr == 1) PG8_BAR;
        PG8_WAIT_V(4); PG8_BAR;
        PG8_STAGE(PG8_SB(1, 0), cB + kstep, voffB); PG8_STAGE(PG8_SA(1, 0), cA + kstep, voffA); PG8_STAGE(PG8_SB(1, 1), cB + hstep + kstep, voffB);
        PG8_WAIT_V(6); PG8_BAR;
    }
    for (;;) {
        const bool has_next = S.next(ui + 1, nxt);
        const char* nA = has_next ? (const char*)g.A + (size_t)nxt.pm * tstep : cA; const char* nB = has_next ? (const char*)g.Bt + (size_t)nxt.pn * tstep : cB;
        for (int t = 0; t < nt; t += 2) {
            const bool last = (t == nt - 2);
            const char* a1 = cA + (size_t)(t + 1) * kstep;
            const char* a2 = last ? nA : cA + (size_t)(t + 2) * kstep; const char* b2 = last ? nB : cB + (size_t)(t + 2) * kstep;
            const char* a3 = a2 + kstep; const char* b3 = b2 + kstep;
            if (last && has_next) S.a_ready(nxt);
            if constexpr (SP2) {
            PG8_LDB(B0, 0, 0); PG8_LDB(B1, 0, 1); PG8_SCHED; PG8_LDA(At, 0, 0); PG8_STAGE(PG8_SA(1, 1), a1 + hstep, voffA);
            PG8_WAIT_V(8); PG8_WAIT_L(0); PG8_BAR; PG8_MMA(0, 0, At, B0); PG8_MMA(0, 1, At, B1); PG8_BAR; PG8_SCHED;
            PG8_LDA(At, 0, 1); PG8_STAGE(PG8_SB(0, 0), b2, voffB); PG8_STAGE(PG8_SB(0, 1), b2 + hstep, voffB); PG8_STAGE(PG8_SA(0, 0), a2, voffA);
            PG8_WAIT_V(8); PG8_WAIT_L(0); PG8_BAR; PG8_MMA(1, 0, At, B0); PG8_MMA(1, 1, At, B1); PG8_BAR; PG8_SCHED;
            PG8_LDB(B0, 1, 0); PG8_LDB(B1, 1, 1); PG8_SCHED; PG8_LDA(At, 1, 0); PG8_STAGE(PG8_SA(0, 1), a2 + hstep, voffA);
            PG8_WAIT_V(8); PG8_WAIT_L(0); PG8_BAR; PG8_MMA(0, 0, At, B0); PG8_MMA(0, 1, At, B1); PG8_BAR; PG8_SCHED;
            PG8_LDA(At, 1, 1); PG8_STAGE(PG8_SB(1, 0), b3, voffB); PG8_STAGE(PG8_SB(1, 1), b3 + hstep, voffB); PG8_STAGE(PG8_SA(1, 0), a3, voffA);
            PG8_WAIT_V(8); PG8_WAIT_L(0); PG8_BAR; PG8_MMA(1, 0, At, B0); PG8_MMA(1, 1, At, B1); PG8_BAR; PG8_SCHED;
            } else {
            PG8_LDB(B0, 0, 0); PG8_SCHED; PG8_LDA(At, 0, 0); PG8_STAGE(PG8_SA(1, 1), a1 + hstep, voffA);
            PG8_WAIT_L(8); PG8_BAR; PG8_WAIT_L(0); PG8_MMA(0, 0, At, B0); PG8_BAR; PG8_SCHED;
            PG8_LDB(B1, 0, 1); PG8_STAGE(PG8_SB(0, 0), b2, voffB);
            PG8_BAR; PG8_WAIT_L(0); PG8_MMA(0, 1, At, B1); PG8_BAR;
            PG8_LDA(At, 0, 1); PG8_STAGE(PG8_SA(0, 0), a2, voffA);
            PG8_BAR; PG8_WAIT_L(0); PG8_MMA(1, 0, At, B0); PG8_BAR; PG8_SCHED;
            PG8_STAGE(PG8_SB(0, 1), b2 + hstep, voffB);
            PG8_WAIT_V(6); PG8_BAR; PG8_MMA(1, 1, At, B1); PG8_BAR;
            PG8_LDB(B0, 1, 0); PG8_SCHED; PG8_LDA(At, 1, 0); PG8_STAGE(PG8_SA(0, 1), a2 + hstep, voffA);
            PG8_WAIT_L(8); PG8_BAR; PG8_WAIT_L(0); PG8_MMA(0, 0, At, B0); PG8_BAR; PG8_SCHED;
            PG8_LDB(B1, 1, 1); PG8_STAGE(PG8_SB(1, 0), b3, voffB);
            PG8_BAR; PG8_WAIT_L(0); PG8_MMA(0, 1, At, B1); PG8_BAR;
            PG8_LDA(At, 1, 1); PG8_STAGE(PG8_SA(1, 0), a3, voffA);
            PG8_BAR; PG8_WAIT_L(0); PG8_MMA(1, 0, At, B0); PG8_BAR; PG8_SCHED;
            PG8_STAGE(PG8_SB(1, 1), b3 + hstep, voffB);
            PG8_WAIT_V(6); PG8_BAR; PG8_MMA(1, 1, At, B1); PG8_BAR;
            }
        }
        if constexpr (ALIGN_EPI) { if (wr == 0) PG8_BAR; }
        if constexpr (!Epi::AFTER_DRAIN) { E(acc, cur, wr, wc, fr, fq); S.done(cur); }
        if (!has_next) break;
#pragma unroll
        for (int a = 0; a < 2; ++a)
#pragma unroll
            for (int b = 0; b < 2; ++b)
#pragma unroll
                for (int m = 0; m < 4; ++m)
#pragma unroll
                    for (int n = 0; n < 2; ++n) acc[a][b][m][n] = (f32x4){0.f, 0.f, 0.f, 0.f};
        cur = nxt; cA = nA; cB = nB; ++ui;
        if constexpr (ALIGN_EPI) { if (wr == 1) PG8_BAR; }
    }
    PG8_WAIT_V(0);
    if constexpr (!ALIGN_EPI) { if (wr == 0) PG8_BAR; }
    PG8_BAR;
    if constexpr (Epi::AFTER_DRAIN) { E.fused(acc, cur, wr, wc, fr, fq, lds, wid, lane); S.done(cur); }
#undef PG8_SA
#undef PG8_SB
#undef PG8_STAGE
#undef PG8_LDA
#undef PG8_LDB
#undef PG8_MMA
#undef PG8_WAIT_V
#undef PG8_WAIT_L
#undef PG8_BAR
#undef PG8_SCHED
}
}

#include <hip/hip_bf16.h>
namespace attn_body {
using bf16=__hip_bfloat16;
using bf16x8=__attribute__((ext_vector_type(8)))short;
using s16x4=__attribute__((ext_vector_type(4)))short;
using f32x16=__attribute__((ext_vector_type(16)))float;
using u32x4=__attribute__((ext_vector_type(4)))unsigned;
constexpr int D=64,PQ=1024,PO=2048;
constexpr int NW=8,QBLK=32,QB=QBLK*NW,KVBLK=64,KPRE=128;
__device__ __forceinline__ int crow(int r,int hi){return (r&3)+8*(r>>2)+4*hi;}
#define SBAR() __builtin_amdgcn_sched_barrier(0)
__device__ __forceinline__ void cmask(f32x16&p0,f32x16&p1,int jb,int qrel,int hi){
  const float NEG=-INFINITY; int hv=hi; asm volatile("":"+v"(hv)); int kb=64*jb+4*hv;
  #pragma unroll
  for(int r=0;r<16;++r){int kv=kb+(r&3)+8*(r>>2); if(kv>qrel)p0[r]=NEG; if(kv+32>qrel)p1[r]=NEG;}
}

constexpr int NSLOT=3, SLOTB=8192;
constexpr int LDS_K=0, LDS_V=NSLOT*SLOTB, LDS_WS=2*NSLOT*SLOTB, LDS_OST=LDS_WS+NW*64*4, LDS_BYTES=LDS_OST+NW*4096;
constexpr float C2=0.125f*1.4426950408889634f;
__device__ __forceinline__ void glds16(const void*gsrc,unsigned lds_dst){unsigned keep;
  asm volatile("s_mov_b32 %0, m0\n\ts_mov_b32 m0, %2\n\ts_nop 0\n\tglobal_load_lds_dwordx4 %1, off\n\ts_mov_b32 m0, %0":"=&s"(keep):"v"(gsrc),"s"(lds_dst):"memory");}
__device__ __forceinline__ float max3f(float a,float b,float c){float r;asm("v_max3_f32 %0, %1, %2, %3":"=v"(r):"v"(a),"v"(b),"v"(c));return r;}
__device__ __forceinline__ float max2f(float a,float b){float r;asm("v_max_f32_e32 %0, %1, %2":"=v"(r):"v"(a),"v"(b));return r;}
__device__ __forceinline__ float fadd_s(float a,float b){float r;asm("v_add_f32_e32 %0, %1, %2":"=v"(r):"v"(a),"v"(b));return r;}
__device__ __forceinline__ float fsub_s(float a,float b){float r;asm("v_sub_f32_e32 %0, %1, %2":"=v"(r):"v"(a),"v"(b));return r;}
typedef float f32x2_t __attribute__((ext_vector_type(2))); typedef __bf16 bf16x2_t __attribute__((ext_vector_type(2)));
__device__ __forceinline__ unsigned cvtpk_s(float lo,float hi){f32x2_t v={lo,hi};bf16x2_t b=__builtin_convertvector(v,bf16x2_t);return __builtin_bit_cast(unsigned,b);}
#define WAIT_BAR(N) asm volatile("s_waitcnt vmcnt(" #N ") lgkmcnt(0)\n\ts_barrier":::"memory")

__device__ __forceinline__ void qkt(f32x16&p0,f32x16&p1,const char*Kslot,const bf16x8*qr,const f32x16&negm,int r32,int hi){
  const char*kb=Kslot+hi*1024+r32*16;
  #pragma unroll
  for(int d0=0;d0<4;++d0){
    const bf16x8 b0=*reinterpret_cast<const bf16x8*>(kb+d0*2048);
    const bf16x8 b1=*reinterpret_cast<const bf16x8*>(kb+d0*2048+512);
    if(d0==0){p0=__builtin_amdgcn_mfma_f32_32x32x16_bf16(b0,qr[0],negm,0,0,0);p1=__builtin_amdgcn_mfma_f32_32x32x16_bf16(b1,qr[0],negm,0,0,0);}
    else{p0=__builtin_amdgcn_mfma_f32_32x32x16_bf16(b0,qr[d0],p0,0,0,0);p1=__builtin_amdgcn_mfma_f32_32x32x16_bf16(b1,qr[d0],p1,0,0,0);}}
}
typedef __attribute__((address_space(3))) const char* lds_cptr;
typedef short v4i16_t __attribute__((ext_vector_type(4)));
__device__ __forceinline__ void kload8(bf16x8*kf,lds_cptr kp){
  kf[0]=*(const __attribute__((address_space(3))) bf16x8*)(kp);      kf[1]=*(const __attribute__((address_space(3))) bf16x8*)(kp+512);
  kf[2]=*(const __attribute__((address_space(3))) bf16x8*)(kp+2048); kf[3]=*(const __attribute__((address_space(3))) bf16x8*)(kp+2560);
  kf[4]=*(const __attribute__((address_space(3))) bf16x8*)(kp+4096); kf[5]=*(const __attribute__((address_space(3))) bf16x8*)(kp+4608);
  kf[6]=*(const __attribute__((address_space(3))) bf16x8*)(kp+6144); kf[7]=*(const __attribute__((address_space(3))) bf16x8*)(kp+6656);
}
__device__ __forceinline__ void kload2(bf16x8*kf,lds_cptr kp,int j){ kf[2*j]=*(const __attribute__((address_space(3))) bf16x8*)(kp+j*2048); kf[2*j+1]=*(const __attribute__((address_space(3))) bf16x8*)(kp+j*2048+512); }
__device__ __forceinline__ s16x4 vtr(lds_cptr p){ return __builtin_bit_cast(s16x4,__builtin_amdgcn_ds_read_tr16_b64_v4i16((__attribute__((address_space(3))) v4i16_t*)p)); }
__device__ __forceinline__ float rowmax(const f32x16&p0,const f32x16&p1){
  float a=max3f(p0[0],p0[1],p1[0]),b=max3f(p0[2],p0[3],p1[1]);a=max3f(a,p1[2],p1[3]);
  #pragma unroll
  for(int r=4;r<16;r+=4){a=max3f(a,p0[r],p0[r+1]);b=max3f(b,p0[r+2],p0[r+3]);a=max3f(a,p1[r],p1[r+1]);b=max3f(b,p1[r+2],p1[r+3]);}
  const float m=max2f(a,b);
  auto rr=__builtin_amdgcn_permlane32_swap(__float_as_uint(m),__float_as_uint(m),false,false);
  return max2f(__uint_as_float(rr[0]),__uint_as_float(rr[1]));
}
__device__ __forceinline__ void pv(f32x16*o,int vb,bf16x8 pa0,bf16x8 pa1,bf16x8 pa2,bf16x8 pa3){
  #pragma unroll
  for(int d0=0;d0<2;++d0){s16x4 lo[4],hi[4];
    #pragma unroll
    for(int ks=0;ks<4;++ks){
      asm volatile("ds_read_b64_tr_b16 %0,%1 offset:%c2":"=&v"(lo[ks]):"v"(vb),"i"(d0*4096+ks*1024):"memory");
      asm volatile("ds_read_b64_tr_b16 %0,%1 offset:%c2":"=&v"(hi[ks]):"v"(vb),"i"(d0*4096+ks*1024+512):"memory");}
    asm volatile("s_waitcnt lgkmcnt(0)":::"memory");SBAR();
    #define PK(k) (bf16x8){lo[k][0],lo[k][1],lo[k][2],lo[k][3],hi[k][0],hi[k][1],hi[k][2],hi[k][3]}
    o[d0]=__builtin_amdgcn_mfma_f32_32x32x16_bf16(pa0,PK(0),o[d0],0,0,0);
    o[d0]=__builtin_amdgcn_mfma_f32_32x32x16_bf16(pa1,PK(1),o[d0],0,0,0);
    o[d0]=__builtin_amdgcn_mfma_f32_32x32x16_bf16(pa2,PK(2),o[d0],0,0,0);
    o[d0]=__builtin_amdgcn_mfma_f32_32x32x16_bf16(pa3,PK(3),o[d0],0,0,0);
    #undef PK
  }
}

#ifndef ATTN_STORE16
#define ATTN_STORE16(p,v) (*(u32x4*)(p)=(v))
#endif
template<int THRL> __device__ __forceinline__ void attn_unit(int qrow0,int krow0,int qb,int qcol,int vcol,int ocol,float sl2,const bf16*Q,const bf16*__restrict__ K,const bf16*__restrict__ V,bf16*O,char*shm){
  const int tid=threadIdx.x; int lane_=tid&63; asm volatile("":"+v"(lane_));
  const int lane=lane_,r32=lane&31,hi=lane>>5; const int wid=__builtin_amdgcn_readfirstlane(tid>>6);
  const int q0=qb*QB; constexpr int DM=PQ;
  const bf16*Qw=Q+(long)(qrow0+wid*QBLK)*DM+qcol;
  const bf16*Kh=K+(long)krow0*DM+qcol,*Vh=V+(long)krow0*DM+vcol;
  const float pos_last=(float)(16+q0+255), lanepart=sl2*(float)(4*hi);
  const unsigned lds0=(unsigned)(uintptr_t)shm;
  float*wsf=(float*)(shm+LDS_WS)+wid*64;
  const bf16*ksrc=Kh+(long)lane*DM+wid*8;
  const bf16*vsrc=Vh+(long)(16*(wid&3)+(lane>>2))*DM+(wid>>2)*32+(lane&3)*8;
  const unsigned kdst=lds0+LDS_K+wid*1024, vdst=lds0+LDS_V+wid*1024;
  #define DMA_K(t,slot) glds16(ksrc+(long)(t)*KVBLK*DM,(unsigned)__builtin_amdgcn_readfirstlane(kdst+(slot)))
  #define DMA_V(t,slot) glds16(vsrc+(long)(t)*KVBLK*DM,(unsigned)__builtin_amdgcn_readfirstlane(vdst+(slot)))
  const int vb0=(int)(lds0+LDS_V)+((lane>>4)&1)*32+(lane&3)*8+(4*hi+((lane&15)>>2))*64;
  const char*Kbase=shm+LDS_K; bf16x8 kf[8];
  const lds_cptr shm3=(lds_cptr)shm; const lds_cptr kp0=shm3+LDS_K+hi*1024+r32*16; const lds_cptr vp0=shm3+LDS_V+((lane>>4)&1)*32+(lane&3)*8+(4*hi+((lane&15)>>2))*64;
  const int NT=(KPRE+q0+QB)/KVBLK;
  DMA_K(0,0);DMA_V(0,0);DMA_K(1,SLOTB);
  bf16x8 qr[4];
  #pragma unroll
  for(int d0=0;d0<4;++d0)qr[d0]=*reinterpret_cast<const bf16x8*>(&Qw[(long)r32*DM+d0*16+hi*8]);
  float mhat=0.f,l_reg=0.f;f32x16 o[2];o[0]=f32x16{};o[1]=f32x16{};const f32x16 negm=f32x16{};
  const int qrel=wid*QBLK+r32;
  #define CMASK(P0,P1,t) do{int jb_=(t)-(NT-4); if(jb_>=0)cmask(P0,P1,jb_,qrel,hi);}while(0)
  #define ABIAS(P0,P1,t) do{ const float tb_=((t)==1)?-INFINITY:sl2*((float)(64*(t)-112)-pos_last); const float b0_=tb_+lanepart-mhat, b1_=b0_+32.f*sl2; \
    _Pragma("unroll") for(int r=0;r<16;++r){ const float cr_=(float)((r&3)+8*(r>>2)); P0[r]=fmaf(sl2,cr_,P0[r]+b0_); P1[r]=fmaf(sl2,cr_,P1[r]+b1_);} }while(0)
  #define ABIAS0(P0,P1) do{ const float b0_=lanepart-sl2*pos_last; \
    _Pragma("unroll") for(int r=0;r<16;++r){ const float cr_=(float)((r&3)+8*(r>>2)); P0[r]=(r<8)?fmaf(sl2,cr_,P0[r]+b0_):-INFINITY; P1[r]=-INFINITY;} }while(0)
  bool resc=false;
  #define START(P0,P1) do{ const float rm=rowmax(P0,P1); resc=false; \
    { const float dl=rm; mhat=fadd_s(mhat,dl); \
      _Pragma("unroll") for(int r=0;r<16;++r){P0[r]=fsub_s(P0[r],dl);P1[r]=fsub_s(P1[r],dl);} \
      } \
    _Pragma("unroll") for(int r=0;r<16;++r)P0[r]=__builtin_amdgcn_exp2f(P0[r]); }while(0)
  #define RESC() do{ if(resc){ asm volatile("s_waitcnt lgkmcnt(0)":::"memory"); \
      _Pragma("unroll") for(int d_=0;d_<2;++d_) _Pragma("unroll") for(int r=0;r<16;++r)o[d_][r]*=wsf[crow(r,hi)]; } }while(0)
  f32x16 pA0,pA1,pB0,pB1;
  int sl_prev=0,sl_cur=0,sl_next=SLOTB;
  #define ROT() do{sl_prev=sl_cur;sl_cur=sl_next;sl_next=(sl_next==(NSLOT-1)*SLOTB)?0:sl_next+SLOTB;}while(0)
  DMA_K(2,2*SLOTB);
  WAIT_BAR(3);
  qkt(pA0,pA1,Kbase,qr,negm,r32,hi);asm volatile("s_nop 15\n\ts_nop 7":"+v"(pA0),"+v"(pA1));ABIAS0(pA0,pA1);
  START(pA0,pA1);
  _Pragma("unroll") for(int r=0;r<16;++r)pA1[r]=__builtin_amdgcn_exp2f(pA1[r]);
  WAIT_BAR(0);
  DMA_K(3,0);DMA_V(1,SLOTB);
  ROT();
  kload8(kf,kp0+sl_cur);
  WAIT_BAR(2);
  s16x4 vlo[8],vhi[8]; u32x4 pw0,pw1,pw2,pw3;
  #define PKW(P,B) cvtpk_s(P[B],P[B+1])
  #define PAF(k) __builtin_bit_cast(bf16x8,pw##k)
  #define VFR(i) (bf16x8){vlo[i][0],vlo[i][1],vlo[i][2],vlo[i][3],vhi[i][0],vhi[i][1],vhi[i][2],vhi[i][3]}
  #define PIN(x) asm volatile("":"+v"(x))
  #define MX3(a,b,c) __builtin_fmaxf(__builtin_fmaxf((a),(b)),(c))
  #define GAPA(MF,A0,A1,A2,A3,W0,W1,PW) do{ MF; sacc+=A0; sacc+=A1; sacc+=A2; sacc+=A3; PIN(sacc); W0; W1; PIN(PW); SBAR(); }while(0)
  #define EX(v) __builtin_amdgcn_exp2f(v)
  #define GAPB(MF,X,B) do{ MF; X[B]=EX(X[B]); X[B+1]=EX(X[B+1]); X[B+2]=EX(X[B+2]); X[B+3]=EX(X[B+3]); PIN(X); SBAR(); }while(0)
  #define VRD(i) do{ vlo[i]=vtr(vp_+(((i)>>2)*4096+((i)&3)*1024)); vhi[i]=vtr(vp_+(((i)>>2)*4096+((i)&3)*1024+512)); }while(0)
  #define KRD(G,j) do{ if(G){ kload2(kf,kp0+sl_next,j); SBAR(); } }while(0)
  #define STEP(C0,C1,P0,P1,t,GK,GV,GL) do{ SBAR(); \
    const lds_cptr vp_=vp0+sl_prev; \
    VRD(0); SBAR(); float sacc=(P0[0]+P0[1]); \
    GAPA(C0=__builtin_amdgcn_mfma_f32_32x32x16_bf16(kf[0],qr[0],negm,0,0,0), P0[2],P0[3],P0[4],P0[5],     pw0[0]=PKW(P0,0), pw0[1]=PKW(P0,2), pw0); \
    VRD(4); SBAR(); GAPA(C1=__builtin_amdgcn_mfma_f32_32x32x16_bf16(kf[1],qr[0],negm,0,0,0), P0[6],P0[7],P0[8],P0[9],     pw0[2]=PKW(P0,4), pw0[3]=PKW(P0,6), pw0); \
    VRD(1); SBAR(); GAPA(C0=__builtin_amdgcn_mfma_f32_32x32x16_bf16(kf[2],qr[1],C0,0,0,0),   P0[10],P0[11],P0[12],P0[13], pw1[0]=PKW(P0,8), pw1[1]=PKW(P0,10), pw1); \
    VRD(5); SBAR(); GAPA(C1=__builtin_amdgcn_mfma_f32_32x32x16_bf16(kf[3],qr[1],C1,0,0,0),   P0[14],P0[15],P1[0],P1[1],   pw1[2]=PKW(P0,12),pw1[3]=PKW(P0,14), pw1); \
    VRD(2); SBAR(); GAPA(C0=__builtin_amdgcn_mfma_f32_32x32x16_bf16(kf[4],qr[2],C0,0,0,0),   P1[2],P1[3],P1[4],P1[5],     pw2[0]=PKW(P1,0), pw2[1]=PKW(P1,2), pw2); \
    VRD(6); SBAR(); GAPA(C1=__builtin_amdgcn_mfma_f32_32x32x16_bf16(kf[5],qr[2],C1,0,0,0),   P1[6],P1[7],P1[8],P1[9],     pw2[2]=PKW(P1,4), pw2[3]=PKW(P1,6), pw2); \
    VRD(3); SBAR(); GAPA(C0=__builtin_amdgcn_mfma_f32_32x32x16_bf16(kf[6],qr[3],C0,0,0,0),   P1[10],P1[11],P1[12],P1[13], pw3[0]=PKW(P1,8), pw3[1]=PKW(P1,10), pw3); \
    VRD(7); SBAR(); GAPA(C1=__builtin_amdgcn_mfma_f32_32x32x16_bf16(kf[7],qr[3],C1,0,0,0),   P1[14],P1[15],0.f,0.f,       pw3[2]=PKW(P1,12),pw3[3]=PKW(P1,14), pw3); \
    l_reg+=sacc; \
    if(GK){DMA_K((t)+3,sl_cur);} if(GV){DMA_V((t)+1,sl_next);} \
    ABIAS(C0,C1,t); CMASK(C0,C1,t); \
    { float a=MX3(C0[0],C0[1],C1[0]),b=MX3(C0[2],C0[3],C1[1]); a=MX3(a,C1[2],C1[3]); \
      _Pragma("unroll") for(int r=4;r<16;r+=4){a=MX3(a,C0[r],C0[r+1]);b=MX3(b,C0[r+2],C0[r+3]);a=MX3(a,C1[r],C1[r+1]);b=MX3(b,C1[r+2],C1[r+3]);} \
      float rm=__builtin_fmaxf(a,b); { auto rr=__builtin_amdgcn_permlane32_swap(__float_as_uint(rm),__float_as_uint(rm),false,false); rm=__builtin_fmaxf(__uint_as_float(rr[0]),__uint_as_float(rr[1])); } \
      resc=false; \
      if(__builtin_expect(__any(rm>(float)THRL),0)){ const float dl=__builtin_fmaxf(rm,0.f); mhat+=dl; \
        _Pragma("unroll") for(int r=0;r<16;++r){C0[r]-=dl;C1[r]-=dl;} \
        const float f=__builtin_amdgcn_exp2f(-dl); l_reg*=f; if(hi==0)wsf[r32]=f; resc=true; } } \
    SBAR(); \
    GAPB(o[0]=__builtin_amdgcn_mfma_f32_32x32x16_bf16(PAF(0),VFR(0),o[0],0,0,0), C0,0); \
    GAPB(o[1]=__builtin_amdgcn_mfma_f32_32x32x16_bf16(PAF(0),VFR(4),o[1],0,0,0), C0,4); \
    KRD(GL,0); GAPB(o[0]=__builtin_amdgcn_mfma_f32_32x32x16_bf16(PAF(1),VFR(1),o[0],0,0,0), C0,8); \
    KRD(GL,1); GAPB(o[1]=__builtin_amdgcn_mfma_f32_32x32x16_bf16(PAF(1),VFR(5),o[1],0,0,0), C0,12); \
    KRD(GL,2); GAPB(o[0]=__builtin_amdgcn_mfma_f32_32x32x16_bf16(PAF(2),VFR(2),o[0],0,0,0), C1,0); \
    KRD(GL,3); GAPB(o[1]=__builtin_amdgcn_mfma_f32_32x32x16_bf16(PAF(2),VFR(6),o[1],0,0,0), C1,4); \
    GAPB(o[0]=__builtin_amdgcn_mfma_f32_32x32x16_bf16(PAF(3),VFR(3),o[0],0,0,0), C1,8); \
    GAPB(o[1]=__builtin_amdgcn_mfma_f32_32x32x16_bf16(PAF(3),VFR(7),o[1],0,0,0), C1,12); \
    }while(0)
  int t=1;
  #undef CMASK
  #define CMASK(P0,P1,t) do{}while(0)
  for(;t+5<NT;t+=2){
    STEP(pB0,pB1,pA0,pA1,t,true,true,true);     WAIT_BAR(2); RESC(); ROT();
    STEP(pA0,pA1,pB0,pB1,t+1,true,true,true);   WAIT_BAR(2); RESC(); ROT();
  }
  #undef CMASK
  #define CMASK(P0,P1,t) do{int jb_=(t)-(NT-4); if(jb_>=0)cmask(P0,P1,jb_,qrel,hi);}while(0)
  #define ENDW(tt) do{ if((tt)+3<NT){WAIT_BAR(2);} else if((tt)+2<NT){WAIT_BAR(1);} else {WAIT_BAR(0);} }while(0)
  for(;t+1<NT;t+=2){
    STEP(pB0,pB1,pA0,pA1,t,(t+3<NT),(t+1<NT),(t+1<NT));       ENDW(t);   RESC(); ROT();
    STEP(pA0,pA1,pB0,pB1,t+1,(t+4<NT),(t+2<NT),(t+2<NT));     ENDW(t+1); RESC(); ROT();
  }
  STEP(pB0,pB1,pA0,pA1,NT-1,false,false,false); RESC();
  { float sacc=pB0[0]+pB0[1]; _Pragma("unroll") for(int r=2;r<16;++r)sacc+=pB0[r]; _Pragma("unroll") for(int r=0;r<16;++r)sacc+=pB1[r]; l_reg+=sacc;
    pw0=(u32x4){PKW(pB0,0),PKW(pB0,2),PKW(pB0,4),PKW(pB0,6)};pw1=(u32x4){PKW(pB0,8),PKW(pB0,10),PKW(pB0,12),PKW(pB0,14)};pw2=(u32x4){PKW(pB1,0),PKW(pB1,2),PKW(pB1,4),PKW(pB1,6)};pw3=(u32x4){PKW(pB1,8),PKW(pB1,10),PKW(pB1,12),PKW(pB1,14)};
    SBAR(); pv(o,vb0+sl_cur,PAF(0),PAF(1),PAF(2),PAF(3)); }
  #undef PKW
  #undef PAF
  #undef VFR
  #undef PIN
  #undef MX3
  #undef GAPA
  #undef GAPB
  #undef EX
  #undef VRD
  #undef KRD
  #undef STEP
  #undef ENDW
  { int lane_e=lane; asm volatile("":"+v"(lane_e)); const int lane=lane_e,r32=lane&31,hi=lane>>5;
  {auto rr=__builtin_amdgcn_permlane32_swap(__float_as_uint(l_reg),__float_as_uint(l_reg),false,false);l_reg=__uint_as_float(rr[0])+__uint_as_float(rr[1]);}
  if(hi==0)wsf[32+r32]=l_reg;asm volatile("s_waitcnt lgkmcnt(0)":::"memory");
  float rli[16];
  #pragma unroll
  for(int r=0;r<16;++r)rli[r]=__builtin_amdgcn_rcpf(wsf[32+crow(r,hi)]);
  bf16*Ow=O+(long)(qrow0+wid*QBLK)*PO+ocol;
  { bf16*stg=(bf16*)(shm+LDS_OST)+wid*2048;
    #pragma unroll
    for(int r=0;r<16;++r){const int orow=crow(r,hi);
      #pragma unroll
      for(int d0=0;d0<2;++d0)stg[orow*64+d0*32+r32]=__float2bfloat16(o[d0][r]*rli[r]);}
    asm volatile("s_waitcnt lgkmcnt(0)":::"memory");
    #pragma unroll
    for(int i=0;i<4;++i){const int row=i*8+(lane>>3),ch=lane&7; const u32x4 v=*(const u32x4*)(stg+row*64+ch*8); ATTN_STORE16(Ow+(long)row*PO+ch*8,v);} }
  }
  asm volatile("s_waitcnt lgkmcnt(0)\n\ts_barrier":::"memory");
  #undef DMA_K
  #undef DMA_V
  #undef CMASK
  #undef ABIAS
  #undef ABIAS0
  #undef START
  #undef RESC
  #undef ROT
}
constexpr int ATTN_LDS_BYTES=LDS_BYTES;
#undef SBAR
#undef WAIT_BAR
}

#define XB_TMO      128
#define XB_XCNT(j)  (256  + 64 * (j))
#define XB_XSUB(j)  (1280 + 64 * (j))
#define XB_XGEN(j)  (2304 + 64 * (j))
#define XB_TOP      3328
#define XB_TOPGEN   3392
#define XCD_BAR_WORDS 3456
#define XB_SPIN_CAP (1u << 18)

__device__ __forceinline__ unsigned xb_ld(unsigned* p)              { return __hip_atomic_load(p, __ATOMIC_RELAXED, __HIP_MEMORY_SCOPE_AGENT); }
__device__ __forceinline__ unsigned xb_add(unsigned* p, unsigned v) { return __hip_atomic_fetch_add(p, v, __ATOMIC_RELAXED, __HIP_MEMORY_SCOPE_AGENT); }
__device__ __forceinline__ unsigned xb_xcc_id() { return (unsigned)__builtin_amdgcn_s_getreg((3 << 11) | 20) & 0xFu; }
#define XB_SPIN(cond, bar) do { unsigned _sp = 0; while (cond) { __builtin_amdgcn_s_sleep(1); \
    if ((++_sp & 255u) == 0u) { if (xb_ld(&(bar)[XB_TMO])) break; if (_sp > XB_SPIN_CAP) { atomicAdd(&(bar)[XB_TMO], 1u); break; } } } } while (0)

struct XcdBarrier {
    unsigned* bar; unsigned x;
    volatile LAS unsigned* st;
};

__device__ __forceinline__ XcdBarrier xcd_barrier_post(unsigned* bar, volatile LAS unsigned* st) {
    XcdBarrier b; b.bar = bar; b.x = xb_xcc_id(); b.st = st;
    if (threadIdx.x == 0) (void)xb_add(&bar[XB_XCNT(b.x)], 1u);
    return b;
}
__device__ __forceinline__ void xcd_barrier_complete(unsigned* bar, unsigned x, unsigned& nloc, unsigned& nx) {
    const unsigned G = gridDim.x * gridDim.y * gridDim.z;
    unsigned sum, cnt, mine, sp = 0u;
    for (;;) {
        sum = 0u; cnt = 0u; mine = 0u;
#pragma unroll
        for (unsigned j = 0; j < 16; ++j) { const unsigned c = xb_ld(&bar[XB_XCNT(j)]); sum += c; cnt += (c > 0u) ? 1u : 0u; mine = (j == x) ? c : mine; }
        if (sum == G) break;
        __builtin_amdgcn_s_sleep(1);
        if ((++sp & 255u) == 0u) { if (xb_ld(&bar[XB_TMO])) break; if (sp > XB_SPIN_CAP) { atomicAdd(&bar[XB_TMO], 1u); break; } }
    }
    nloc = mine > 0u ? mine : 1u; nx = cnt > 0u ? cnt : 1u;
}

__device__ __forceinline__ void xcd_barrier(const XcdBarrier& b) {
    asm volatile("s_waitcnt vmcnt(0)" ::: "memory");
    __syncthreads();
    if (threadIdx.x == 0) {
        unsigned* bar = b.bar;
        __builtin_amdgcn_s_waitcnt(0);
        unsigned nloc = b.st[0], nx = b.st[1];
        if (nloc == 0u) { xcd_barrier_complete(bar, b.x, nloc, nx); b.st[0] = nloc; b.st[1] = nx; }
        const unsigned old = xb_add(&bar[XB_XSUB(b.x)], 1u);
        const unsigned gen = old / nloc;
        if (old + 1u == (gen + 1u) * nloc) {
            __builtin_amdgcn_fence(__ATOMIC_RELEASE, "agent");
            asm volatile("s_waitcnt vmcnt(0)" ::: "memory");
            const unsigned og = xb_add(&bar[XB_TOP], 1u);
            const unsigned tg = og / nx;
            if (og + 1u == (tg + 1u) * nx) xb_add(&bar[XB_TOPGEN], 1u);
            else XB_SPIN(xb_ld(&bar[XB_TOPGEN]) == tg, bar);
            __builtin_amdgcn_fence(__ATOMIC_ACQUIRE, "agent");
            xb_add(&bar[XB_XGEN(b.x)], 1u);
            asm volatile("s_waitcnt vmcnt(0)" ::: "memory");
        } else {
            XB_SPIN(xb_ld(&bar[XB_XGEN(b.x)]) == gen, bar);
            __builtin_amdgcn_fence(__ATOMIC_ACQUIRE, "agent");
            asm volatile("s_waitcnt vmcnt(0)" ::: "memory");
        }
    }
    __syncthreads();
}

#endif
constexpr int NWAVES = 8, NTHR = NWAVES * 64;
constexpr int RING_OFF = 0, RING_BYTES = 131072, LDSCTL_OFF = RING_BYTES, MISC_OFF = LDSCTL_OFF + 320, LDS_BYTES = 147456;
struct Frame {
    LAS unsigned char* lds;
    int tid, lane, wave, vcu, G;
    const void* const* in; float* out; unsigned char* ws;
    __device__ __forceinline__ const float* fin(int i) const { return (const float*)in[i]; }
};
struct Args { const void* in[N_IN]; float* out; unsigned char* ws; int ph_lo, ph_hi; };

__device__ __forceinline__ float* xrow_ptr(const Frame& F, int row) {
    if (row < MAIN) return F.out + OFF_YP + (size_t)row * DM;
    if (row < SMP0) return (float*)(F.ws + WS_XX) + (size_t)(row - META0) * DM;
    return F.out + OFF_YS + (size_t)(row - SMP0) * DM;
}
__device__ __forceinline__ const float* x0row_ptr(const Frame& F, int row) {
    if (row < MAIN) return F.fin(I_XP) + (size_t)row * DM;
    if (row < SMP0) return F.fin(I_META) + (size_t)(row - META0) * DM;
    return F.fin(I_XS) + (size_t)(row - SMP0) * DM;
}

__device__ __forceinline__ void wt_item(const float* W, int Nsrc, int srccol0, const float* scale, int k0, bf16* WT, int K, int dstrow0, LAS float* scr, int lane) {
    const int kr = lane >> 4, nq = lane & 15;
    f32x4 v[16];
#pragma unroll
    for (int i = 0; i < 16; ++i) v[i] = *(const f32x4*)(W + (size_t)(k0 + 4 * i + kr) * Nsrc + srccol0 + 4 * nq);
#pragma unroll
    for (int i = 0; i < 16; ++i) { const int k = 4 * i + kr; const float sc = scale ? scale[k0 + k] : 1.0f; *(LAS f32x4*)(scr + k * 64 + ((4 * nq) ^ (8 * (k >> 3)))) = v[i] * sc; }
    px_wave_sync();
    const int c = lane & 7;
#pragma unroll
    for (int j = 0; j < 8; ++j) { const int n = (lane >> 3) + 8 * j; const LAS float* s = scr + (8 * c) * 64 + (n ^ (8 * c));
        u32x4 o; o.x = px_cvtpk(s[0 * 64], s[1 * 64]); o.y = px_cvtpk(s[2 * 64], s[3 * 64]); o.z = px_cvtpk(s[4 * 64], s[5 * 64]); o.w = px_cvtpk(s[6 * 64], s[7 * 64]);
        *(u32x4*)(WT + (size_t)(dstrow0 + n) * K + k0 + 8 * c) = o; }
    px_wave_sync();
}
constexpr int WI_IN0 = (DM / 64) * (NIN0 / 64), WI_SQ = (DM / 64) * (DM / 64), WI_GU = (DM / 64) * (NGU / 64), WI_D = (DFF / 64) * (DM / 64);
constexpr int WI_TOTAL = WI_IN0 + 4 * WI_SQ + 2 * WI_GU + 2 * WI_D;
__device__ __forceinline__ void p0_weight_item(const Frame& F, int it, LAS float* scr) {
    int r = it;
    if (r < WI_IN0) { const int nb = r % (NIN0 / 64), kb = r / (NIN0 / 64), n0 = nb * 64; int sc;
        if (n0 < 3072) sc = n0; else { const int j = (n0 - 3072) >> 8, o = (n0 - 3072) & 255; sc = (o < 128) ? 3072 + 128 * j + o : 4096 + 128 * j + (o - 128); }
        wt_item(F.fin(I_WIN0), NIN0, sc, F.fin(I_NMPRE), kb * 64, (bf16*)(F.ws + WS_WIN0), DM, n0, scr, F.lane); return; } r -= WI_IN0;
    if (r < WI_SQ) { wt_item(F.fin(I_WOUT0), DM, (r % 32) * 64, nullptr, (r / 32) * 64, (bf16*)(F.ws + WS_WOUT0), DM, (r % 32) * 64, scr, F.lane); return; } r -= WI_SQ;
    if (r < WI_SQ) { wt_item(F.fin(I_WIN1), DM, (r % 32) * 64, F.fin(I_NMPRE) + DM, (r / 32) * 64, (bf16*)(F.ws + WS_WIN1), DM, (r % 32) * 64, scr, F.lane); return; } r -= WI_SQ;
    if (r < WI_SQ) { wt_item(F.fin(I_WGLU), DM, (r % 32) * 64, nullptr, (r / 32) * 64, (bf16*)(F.ws + WS_WGLU), DM, (r % 32) * 64, scr, F.lane); return; } r -= WI_SQ;
    if (r < WI_SQ) { wt_item(F.fin(I_WOUT1), DM, (r % 32) * 64, nullptr, (r / 32) * 64, (bf16*)(F.ws + WS_WOUT1), DM, (r % 32) * 64, scr, F.lane); return; } r -= WI_SQ;
    if (r < 2 * WI_GU) { const int l = r / WI_GU; r -= l * WI_GU; const int nb = r % (NGU / 64), kb = r / (NGU / 64), n0 = nb * 64, j = n0 >> 8, o = n0 & 255;
        const float* W = (o < 128 ? F.fin(I_WG) : F.fin(I_WU)) + (size_t)l * DM * DFF;
        wt_item(W, DFF, 128 * j + (o & 127), F.fin(I_NFPRE) + l * DM, kb * 64, (bf16*)(F.ws + (l ? WS_WGU1 : WS_WGU0)), DM, n0, scr, F.lane); return; } r -= 2 * WI_GU;
    { const int l = r / WI_D; r -= l * WI_D; const int nb = r % 32, kb = r / 32;
        wt_item(F.fin(I_WD) + (size_t)l * DFF * DM, DM, nb * 64, nullptr, kb * 64, (bf16*)(F.ws + (l ? WS_WD1 : WS_WD0)), DFF, nb * 64, scr, F.lane); }
}
__device__ __forceinline__ void row_to_xb(const Frame& F, const float* xr, int row) {
    bf16* xb = (bf16*)(F.ws + WS_XB) + (size_t)row * DM; float* rs = (float*)(F.ws + WS_RS);
    f32x4 v[8]; float ss = 0.f;
#pragma unroll
    for (int j = 0; j < 8; ++j) { v[j] = *(const f32x4*)(xr + 4 * F.lane + 256 * j); ss += (v[j][0] * v[j][0] + v[j][1] * v[j][1]) + (v[j][2] * v[j][2] + v[j][3] * v[j][3]); }
    ss = wave_sum(ss);
#pragma unroll
    for (int j = 0; j < 8; ++j) { u32x2 w; w.x = pk2(v[j][0], v[j][1]); w.y = pk2(v[j][2], v[j][3]); *(u32x2*)(xb + 4 * F.lane + 256 * j) = w; }
    if (F.lane == 0) rs[row] = px_rsq(ss * (1.0f / DM) + EPSN);
}
__device__ __forceinline__ void p0_ssm_params(const Frame& F, int gp) {
    const int g = gp >> 6, p = gp & 63;
    const double are = F.fin(I_ARE)[gp], aim = F.fin(I_AIM)[gp], dt = exp((double)F.fin(I_LDT)[g]);
    const double mag = exp(are * dt); double sn, cs; sincos(aim * dt, &sn, &cs);
    const double abr = mag * cs, abi = mag * sn;
    const double nr = abr - 1.0, ni = abi, den = are * are + aim * aim;
    const double cr = (nr * are + ni * aim) / den, ci = (ni * are - nr * aim) / den;
    f32x2* AB = (f32x2*)(F.ws + WS_PAR + PAR_ABAR); AB[gp] = (f32x2){(float)abr, (float)abi};
    f32x2* PW = (f32x2*)(F.ws + WS_PAR + PAR_PW);
    for (int i = 0; i < 9; ++i) { const double k = 256.0 * i, mg = exp(are * dt * k); double s2, c2; sincos(aim * dt * k, &s2, &c2); PW[(g * 9 + i) * 64 + p] = (f32x2){(float)(mg * c2), (float)(mg * s2)}; }
    bf16* BBT = (bf16*)(F.ws + WS_PAR + PAR_BBT) + (size_t)g * 2048; bf16* CCT = (bf16*)(F.ws + WS_PAR + PAR_CCT) + (size_t)g * 2048;
    const int cb = (p >> 5) * 2, n = p & 31;
    for (int c = 0; c < 16; ++c) { const double br = F.fin(I_BRE)[gp * 16 + c], bi = F.fin(I_BIM)[gp * 16 + c];
        BBT[((cb + 0) * 32 + n) * 16 + c] = (bf16)f2bf((float)(cr * br - ci * bi)); BBT[((cb + 1) * 32 + n) * 16 + c] = (bf16)f2bf((float)(cr * bi + ci * br));
        CCT[c * 128 + 2 * p] = (bf16)f2bf(F.fin(I_CRE)[(g * 16 + c) * 64 + p]); CCT[c * 128 + 2 * p + 1] = (bf16)f2bf(-F.fin(I_CIM)[(g * 16 + c) * 64 + p]); }
}
__device__ __forceinline__ void p0_prologue(const Frame& F) {
    const int gw = F.vcu * NWAVES + F.wave, NGW = F.G * NWAVES;
    for (int row = gw; row < MP; row += NGW) { if (!EMU_UNIT_OK(WI_TOTAL + row)) continue;
        if (row < NREAL) row_to_xb(F, x0row_ptr(F, row), row);
        else { bf16* xb = (bf16*)(F.ws + WS_XB) + (size_t)row * DM; for (int j = 0; j < 4; ++j) *(u32x4*)(xb + 8 * F.lane + 512 * j) = (u32x4){0u, 0u, 0u, 0u}; if (F.lane == 0) ((float*)(F.ws + WS_RS))[row] = 0.f; } }
    for (int r = gw; r < NBATCH * (TPREF - NMETA); r += NGW) { if (!EMU_UNIT_OK(WI_TOTAL + MP + r)) continue;
        const int b = r / (TPREF - NMETA), j = NMETA + r % (TPREF - NMETA);
        bf16* kb = (bf16*)(F.ws + WS_KB) + (size_t)(b * KROWS + j) * 1024; bf16* vb = (bf16*)(F.ws + WS_VB) + (size_t)(b * KROWS + j) * 1024;
        for (int q = 0; q < 2; ++q) { *(u32x4*)(kb + 8 * F.lane + 512 * q) = (u32x4){0u, 0u, 0u, 0u}; *(u32x4*)(vb + 8 * F.lane + 512 * q) = (u32x4){0u, 0u, 0u, 0u}; } }
    for (int w = gw; w < 128 * NWAVES; w += NGW) if ((w % NWAVES) == 0 && EMU_UNIT_OK(WI_TOTAL + MP + 1024 + (w / NWAVES) * 64)) p0_ssm_params(F, (w / NWAVES) * 64 + F.lane);
    if (gw == 0 && F.lane == 0 && EMU_UNIT_OK(WI_TOTAL + MP + 1024 + 8192)) {
        const float* lq = F.fin(I_LQ); const float* lk = F.fin(I_LK); float s0 = 0.f, s1 = 0.f;
        for (int i = 0; i < 64; ++i) { s0 += lq[i] * lk[i]; s1 += lq[64 + i] * lk[64 + i]; }
        ((float*)(F.ws + WS_PAR + PAR_LAM))[0] = expf(s0) - expf(s1) + 0.2f; }
}

__device__ __forceinline__ void resid_row(const Frame& F, int row, const float* xold, const float* gpost, bool last) {
    const float* mr = (const float*)(F.ws + WS_M) + (size_t)row * DM; float* xn = xrow_ptr(F, row);
    f32x4 mv[8]; float ss = 0.f;
#pragma unroll
    for (int j = 0; j < 8; ++j) { mv[j] = *(const f32x4*)(mr + 4 * F.lane + 256 * j); ss += (mv[j][0] * mv[j][0] + mv[j][1] * mv[j][1]) + (mv[j][2] * mv[j][2] + mv[j][3] * mv[j][3]); }
    const float rm = px_rsq(wave_sum(ss) * (1.0f / DM) + EPSN);
    float s2 = 0.f; bf16* xb = (bf16*)(F.ws + WS_XB) + (size_t)row * DM;
#pragma unroll
    for (int j = 0; j < 8; ++j) { const int c = 4 * F.lane + 256 * j; const f32x4 xo = *(const f32x4*)(xold + c), gp = *(const f32x4*)(gpost + c);
        const f32x4 x = xo + mv[j] * rm * gp; *(f32x4*)(xn + c) = x; s2 += (x[0] * x[0] + x[1] * x[1]) + (x[2] * x[2] + x[3] * x[3]);
        if (!last) { u32x2 w; w.x = pk2(x[0], x[1]); w.y = pk2(x[2], x[3]); *(u32x2*)(xb + c) = w; } }
    s2 = wave_sum(s2);
    if (!last && F.lane == 0) ((float*)(F.ws + WS_RS))[row] = px_rsq(s2 * (1.0f / DM) + EPSN);
}
__device__ __forceinline__ void resid_phase(const Frame& F, const float* gpost, bool first, bool last) {
    const int gw = F.vcu * NWAVES + F.wave, NGW = F.G * NWAVES;
    for (int row = gw; row < NREAL; row += NGW) { if (!EMU_UNIT_OK(row)) continue;
        if (last && row >= META0 && row < SMP0) continue;
        resid_row(F, row, first ? x0row_ptr(F, row) : (const float*)xrow_ptr(F, row), gpost, last); }
}

struct ConvSeg { int kind, b, r0g, nrows, s0; };
__device__ __forceinline__ f32x2 conv_in(const Frame& F, const ConvSeg& sg, int i, int ch) {
    const bf16* Gb = (const bf16*)(F.ws + WS_G);
    if (i >= 0) { const unsigned w = *(const unsigned*)(Gb + (size_t)(sg.r0g + i) * 1024 + ch); return (f32x2){bf_lo(w), bf_hi(w)}; }
    if (sg.kind == 0) { const int s = sg.s0 + i;
        if (s >= 0) { const unsigned w = *(const unsigned*)(Gb + (size_t)(sg.r0g + i) * 1024 + ch); return (f32x2){bf_lo(w), bf_hi(w)}; }
        if (s >= -NMETA) { const unsigned w = *(const unsigned*)(Gb + (size_t)(META0 + NMETA + s) * 1024 + ch); return (f32x2){bf_lo(w), bf_hi(w)}; }
        return (f32x2){0.f, 0.f}; }
    if (sg.kind == 2) { const float* st = F.fin(I_SCONV) + ((size_t)sg.b * 30 + (30 + i)) * 1024 + ch; return (f32x2){st[0], st[1]}; }
    return (f32x2){0.f, 0.f};
}
__device__ __forceinline__ void conv_unit(const Frame& F, const ConvSeg& sg) {
    const int ch = 2 * F.tid;
    LAS float* red = (LAS float*)(F.lds + RING_OFF);
    f32x2 w[31];
#pragma unroll
    for (int j = 0; j < 31; ++j) w[j] = *(const f32x2*)(F.fin(I_CW) + (size_t)j * 1024 + ch);
    const f32x2 cb = *(const f32x2*)(F.fin(I_CB) + ch), lg = *(const f32x2*)(F.fin(I_CLG) + ch), lb = *(const f32x2*)(F.fin(I_CLB) + ch);
    bf16* OC = (bf16*)(F.ws + WS_OC);
    for (int q0 = 0; q0 < sg.nrows; q0 += 8) {
        f32x2 acc[8];
#pragma unroll
        for (int o = 0; o < 8; ++o) acc[o] = cb;
#pragma unroll
        for (int ii0 = 0; ii0 < 40; ii0 += 4) {
            f32x2 xs[4];
            int ib = q0 - 30 + ii0; PX_OPAQUE_S(ib);
#pragma unroll
            for (int k = 0; k < 4; ++k) { const int i = ib + k; xs[k] = (ii0 + k < 38 && i < sg.nrows) ? conv_in(F, sg, i, ch) : (f32x2){0.f, 0.f}; }
#pragma unroll
            for (int k = 0; k < 4; ++k)
#pragma unroll
                for (int o = 0; o < 8; ++o) { const int j = ii0 + k - o; if (j >= 0 && j <= 30) acc[o] = acc[o] + w[j] * xs[k]; }
            asm volatile("" ::: "memory");
        }
        LAS float* rp = red + ((q0 >> 3) & 1) * 128;
#pragma unroll
        for (int o = 0; o < 8; ++o) { const float s1 = wave_sum(acc[o][0] + acc[o][1]), s2 = wave_sum(acc[o][0] * acc[o][0] + acc[o][1] * acc[o][1]);
            if (F.lane == 0) { rp[(o * 8 + F.wave) * 2] = s1; rp[(o * 8 + F.wave) * 2 + 1] = s2; } }
        px_block_sync();
#pragma unroll
        for (int o = 0; o < 8; ++o) { if (q0 + o >= sg.nrows) continue;
            float s1 = 0.f, s2 = 0.f;
#pragma unroll
            for (int wv = 0; wv < 8; ++wv) { s1 += rp[(o * 8 + wv) * 2]; s2 += rp[(o * 8 + wv) * 2 + 1]; }
            const float mean = s1 * (1.0f / 1024.f), var = s2 * (1.0f / 1024.f) - mean * mean, rstd = px_rsq(var + EPSN);
            const float y0 = (acc[o][0] - mean) * rstd * lg[0] + lb[0], y1 = (acc[o][1] - mean) * rstd * lg[1] + lb[1];
            *(unsigned*)(OC + (size_t)(sg.r0g + q0 + o) * DM + 1024 + ch) = pk2(siluf_(y0), siluf_(y1)); }
    }
    px_block_sync();
    if (sg.kind == 2) {
        for (int r = 0; r < 26; ++r) *(f32x2*)(F.out + OFF_CS + ((size_t)sg.b * 30 + r) * 1024 + ch) = *(const f32x2*)(F.fin(I_SCONV) + ((size_t)sg.b * 30 + r + 4) * 1024 + ch); }
}
constexpr int CONV_UNITS = NBATCH * 64 + 1 + 8;
__device__ __forceinline__ void conv_phase_unit(const Frame& F, int u) {
    ConvSeg sg;
    if (u < NBATCH * 64) { sg.kind = 0; sg.b = u >> 6; sg.s0 = (u & 63) * 32; sg.r0g = sg.b * SEQ + sg.s0; sg.nrows = 32; }
    else if (u == NBATCH * 64) { sg.kind = 1; sg.b = 0; sg.s0 = 0; sg.r0g = META0; sg.nrows = NMETA; }
    else { sg.kind = 2; sg.b = u - NBATCH * 64 - 1; sg.s0 = 0; sg.r0g = SMP0 + 4 * sg.b; sg.nrows = 4; }
    conv_unit(F, sg);
}
constexpr int SSM_HROW = 272, SSM_HWAVE = 32 * SSM_HROW + 1024;
__device__ __forceinline__ void ssm_run(const Frame& F, int g, int r0g, int nsteps, f32x2& h, bool do_y) {
    const int lane = F.lane, l31 = lane & 31, hh = lane >> 5, l15 = lane & 15, l4 = lane >> 4;
    const bf16* U = (const bf16*)(F.ws + WS_U); bf16* Y = (bf16*)(F.ws + WS_Y);
    const bf16* BBT = (const bf16*)(F.ws + WS_PAR + PAR_BBT) + (size_t)g * 2048; const bf16* CCT = (const bf16*)(F.ws + WS_PAR + PAR_CCT) + (size_t)g * 2048;
    bf16x8 bbf[4], ccf[4];
#pragma unroll
    for (int cb = 0; cb < 4; ++cb) { bbf[cb] = *(const bf16x8*)(BBT + ((cb * 32 + l31) * 16 + 8 * hh)); ccf[cb] = *(const bf16x8*)(CCT + l15 * 128 + cb * 32 + 8 * l4); }
    const f32x2 ab = ((const f32x2*)(F.ws + WS_PAR + PAR_ABAR))[g * 64 + lane];
    const float dg = F.fin(I_SD)[g * 16 + l15];
    LAS unsigned char* Hl = F.lds + RING_OFF + F.wave * SSM_HWAVE; LAS unsigned char* Ul = Hl + 32 * SSM_HROW;
    float hr = h[0], hi = h[1];
    const bf16x8 zf = (bf16x8){0, 0, 0, 0, 0, 0, 0, 0};
    bf16x8 afn = (l31 < nsteps) ? *(const bf16x8*)(U + (size_t)(r0g + l31) * DM + 16 * g + 8 * hh) : zf;
    for (int t0 = 0; t0 < nsteps; t0 += 32) {
        const bf16x8 af = afn;
        afn = (t0 + 32 + l31 < nsteps) ? *(const bf16x8*)(U + (size_t)(r0g + t0 + 32 + l31) * DM + 16 * g + 8 * hh) : zf;
        if (do_y) *(LAS bf16x8*)(Ul + l31 * 32 + 16 * hh) = af;
        const f32x16 z = {0.f, 0.f, 0.f, 0.f, 0.f, 0.f, 0.f, 0.f, 0.f, 0.f, 0.f, 0.f, 0.f, 0.f, 0.f, 0.f};
        const f32x16 d0 = px_mfma32(af, bbf[0], z), d1 = px_mfma32(af, bbf[1], z), d2 = px_mfma32(af, bbf[2], z), d3 = px_mfma32(af, bbf[3], z);
        float re_e[16], re_o[16], im_e[16], im_o[16];
#pragma unroll
        for (int rg = 0; rg < 16; ++rg) { px_swap32(d0[rg], d2[rg], re_e[rg], re_o[rg]); px_swap32(d1[rg], d3[rg], im_e[rg], im_o[rg]); }
#pragma unroll
        for (int q = 0; q < 4; ++q)
#pragma unroll
            for (int s = 0; s < 2; ++s)
#pragma unroll
                for (int i = 0; i < 4; ++i) { const int rg = 4 * q + i, t = 8 * q + 4 * s + i;
                    const float br = s ? re_o[rg] : re_e[rg], bi = s ? im_o[rg] : im_e[rg];
                    const float nr = ab[0] * hr - ab[1] * hi + br, ni = ab[0] * hi + ab[1] * hr + bi;
                    if (t0 + t < nsteps) { hr = nr; hi = ni; }
                    if (do_y) *(LAS unsigned*)(Hl + t * SSM_HROW + 4 * lane) = pk2(nr, ni); }
        if (do_y) {
            px_wave_sync();
#pragma unroll
            for (int mb = 0; mb < 2; ++mb) {
                f32x4 ya = {0.f, 0.f, 0.f, 0.f};
#pragma unroll
                for (int ks = 0; ks < 4; ++ks) { const bf16x8 hf = *(const LAS bf16x8*)(Hl + (16 * mb + l15) * SSM_HROW + (ks * 32 + 8 * l4) * 2); ya = px_mfma16(hf, ccf[ks], ya); }
#pragma unroll
                for (int r = 0; r < 4; ++r) { const int t = 16 * mb + 4 * l4 + r;
                    if (t0 + t < nsteps) { const size_t off = (size_t)(r0g + t0 + t) * DM + 16 * g + l15; const float y = ya[r] + dg * bf2f(*(const LAS bf16*)(Ul + t * 32 + 2 * l15)); Y[off] = (bf16)f2bf(gelu_tanh(y)); } }
            }
            px_wave_sync();
        }
    }
    h[0] = hr; h[1] = hi;
}
__device__ __forceinline__ f32x2 cmul(f32x2 a, f32x2 b) { return (f32x2){a[0] * b[0] - a[1] * b[1], a[0] * b[1] + a[1] * b[0]}; }
constexpr int S1_MAIN = NBATCH * 7 * 16, S1_UNITS = S1_MAIN + 16 + 8 * 16, S2_UNITS = NBATCH * 8 * 16;
__device__ __forceinline__ void ssm_pass1_unit(const Frame& F, int bu) {
    f32x2* E = (f32x2*)(F.ws + WS_SSME); f32x2* EM = E + (size_t)NBATCH * 8 * 128 * 64;
    if (bu < S1_MAIN) { const int g = (bu & 15) * 8 + F.wave, k = (bu >> 4) % 7, b = (bu >> 4) / 7; f32x2 h = {0.f, 0.f};
        ssm_run(F, g, b * SEQ + 256 * k, 256, h, false); E[((size_t)(b * 8 + k) * 128 + g) * 64 + F.lane] = h; }
    else if (bu < S1_MAIN + 16) { const int g = (bu - S1_MAIN) * 8 + F.wave; f32x2 h = {0.f, 0.f}; ssm_run(F, g, META0, NMETA, h, true); EM[g * 64 + F.lane] = h; }
    else { const int v = bu - S1_MAIN - 16, bs = v >> 4, g = (v & 15) * 8 + F.wave; const size_t si = ((size_t)bs * 128 + g) * 64 + F.lane;
        f32x2 h = {F.fin(I_SSRE)[si], F.fin(I_SSIM)[si]}; ssm_run(F, g, SMP0 + 4 * bs, 4, h, true); F.out[OFF_SRS + si] = h[0]; F.out[OFF_SIS + si] = h[1]; }
}
__device__ __forceinline__ void ssm_pass2_unit(const Frame& F, int bu) {
    const f32x2* E = (const f32x2*)(F.ws + WS_SSME); const f32x2* EM = E + (size_t)NBATCH * 8 * 128 * 64; const f32x2* PW = (const f32x2*)(F.ws + WS_PAR + PAR_PW);
    const int g = (bu & 15) * 8 + F.wave, k = (bu >> 4) & 7, b = bu >> 7;
    f32x2 h = cmul(PW[(g * 9 + k) * 64 + F.lane], EM[g * 64 + F.lane]);
    for (int j = 0; j < k; ++j) h = h + cmul(PW[(g * 9 + (k - 1 - j)) * 64 + F.lane], E[((size_t)(b * 8 + j) * 128 + g) * 64 + F.lane]);
    ssm_run(F, g, b * SEQ + 256 * k, 256, h, true);
    if (k == 7) { const size_t si = ((size_t)b * 128 + g) * 64 + F.lane; F.out[OFF_SRP + si] = h[0]; F.out[OFF_SIP + si] = h[1]; }
}

__device__ __forceinline__ void meta_attn(const Frame& F) {
    const int h = F.wave, lane = F.lane, j = lane & 15, dp = lane >> 4;
    const bf16* Qb = (const bf16*)(F.ws + WS_Q); const bf16* Kb = (const bf16*)(F.ws + WS_KB); const bf16* Vb = (const bf16*)(F.ws + WS_VB); bf16* OC = (bf16*)(F.ws + WS_OC);
    const float lam = ((const float*)(F.ws + WS_PAR + PAR_LAM))[0], sl2 = exp2f(-(float)(h + 1)) * 1.4426950408889634f;
    const f32x2 sg = *(const f32x2*)(F.fin(I_SUBG) + 2 * lane);
    for (int q = 0; q < NMETA; ++q) {
        float on[2][2];
#pragma unroll
        for (int m = 0; m < 2; ++m) {
            const bf16* qp = Qb + (size_t)(META0 + q) * 1024 + (2 * h + m) * 64 + 16 * dp; const bf16* kp = Kb + (size_t)j * 1024 + (2 * h + m) * 64 + 16 * dp;
            float s = 0.f;
#pragma unroll
            for (int e = 0; e < 16; ++e) s += bf2f(qp[e]) * bf2f(kp[e]);
            s += px_shfl_xor(s, 16); s += px_shfl_xor(s, 32);
            s = (j <= q) ? s + sl2 * (float)j : -INFINITY;
            float mx = s;
#pragma unroll
            for (int o = 1; o < 16; o <<= 1) mx = fmaxf(mx, px_shfl_xor(mx, o));
            const float p = px_exp2(s - mx); float l = p;
#pragma unroll
            for (int o = 1; o < 16; o <<= 1) l += px_shfl_xor(l, o);
            float o0 = 0.f, o1 = 0.f;
#pragma unroll
            for (int jj = 0; jj < 16; ++jj) { const float pj = px_shfl(p, jj); const unsigned vv = *(const unsigned*)(Vb + (size_t)jj * 1024 + h * 128 + 2 * lane); o0 += pj * bf_lo(vv); o1 += pj * bf_hi(vv); }
            const float il = 1.0f / l; on[m][0] = o0 * il; on[m][1] = o1 * il;
        }
        const float c0 = on[0][0] - lam * on[1][0], c1 = on[0][1] - lam * on[1][1];
        const float rstd = px_rsq(wave_sum(c0 * c0 + c1 * c1) * (1.0f / 128.f) + EPSN) * 0.8f;
        *(unsigned*)(OC + (size_t)(META0 + q) * DM + h * 128 + 2 * lane) = pk2(c0 * rstd * sg[0], c1 * rstd * sg[1]);
    }
}
__device__ __forceinline__ void combine_row(const Frame& F, int row) {
    const bf16* O2 = (const bf16*)(F.ws + WS_O2) + (size_t)row * 2048; bf16* OC = (bf16*)(F.ws + WS_OC) + (size_t)row * DM;
    const int h = F.lane >> 3, sub = F.lane & 7; const float lam = ((const float*)(F.ws + WS_PAR + PAR_LAM))[0];
    const u32x4 a0 = *(const u32x4*)(O2 + (2 * h) * 128 + 16 * sub), a1 = *(const u32x4*)(O2 + (2 * h) * 128 + 16 * sub + 8);
    const u32x4 b0 = *(const u32x4*)(O2 + (2 * h + 1) * 128 + 16 * sub), b1 = *(const u32x4*)(O2 + (2 * h + 1) * 128 + 16 * sub + 8);
    float c[16]; float ss = 0.f;
#pragma unroll
    for (int i = 0; i < 4; ++i) { c[2 * i] = bf_lo(a0[i]) - lam * bf_lo(b0[i]); c[2 * i + 1] = bf_hi(a0[i]) - lam * bf_hi(b0[i]); c[8 + 2 * i] = bf_lo(a1[i]) - lam * bf_lo(b1[i]); c[8 + 2 * i + 1] = bf_hi(a1[i]) - lam * bf_hi(b1[i]); }
#pragma unroll
    for (int i = 0; i < 16; ++i) ss += c[i] * c[i];
    ss += px_shfl_xor(ss, 1); ss += px_shfl_xor(ss, 2); ss += px_shfl_xor(ss, 4);
    const float rstd = px_rsq(ss * (1.0f / 128.f) + EPSN) * 0.8f; const float* sg = F.fin(I_SUBG) + 16 * sub;
    u32x4 w0, w1;
#pragma unroll
    for (int i = 0; i < 4; ++i) { w0[i] = pk2(c[2 * i] * rstd * sg[2 * i], c[2 * i + 1] * rstd * sg[2 * i + 1]); w1[i] = pk2(c[8 + 2 * i] * rstd * sg[8 + 2 * i], c[8 + 2 * i + 1] * rstd * sg[8 + 2 * i + 1]); }
    *(u32x4*)(OC + h * 128 + 16 * sub) = w0; *(u32x4*)(OC + h * 128 + 16 * sub + 8) = w1;
}

typedef float f32x8 __attribute__((ext_vector_type(8)));
constexpr int DEC_UNITS = 8 * 8 * NSD, DEC_PPS = (PASTLEN / 16) / NSD, DEC_PPW = DEC_PPS / 8;
constexpr int DLDS_P = 0, DLDS_MRG = 8 * 64 * 2, DMRG_REC = 4 + 128;
static_assert(DEC_PPW <= 64 && DEC_PPW >= 1, "decode split");
__device__ __forceinline__ float u2f(unsigned u) { return __builtin_bit_cast(float, u); }
__device__ __forceinline__ u32x4 tobf8(u32x4 a, u32x4 b) { u32x4 w; w.x = px_cvtpk(u2f(a.x), u2f(a.y)); w.y = px_cvtpk(u2f(a.z), u2f(a.w)); w.z = px_cvtpk(u2f(b.x), u2f(b.y)); w.w = px_cvtpk(u2f(b.z), u2f(b.w)); return w; }
__device__ __forceinline__ float xrow16_max(float x) { float a, b; px_swap16(x, x, a, b); x = fmaxf(a, b); px_swap32(x, x, a, b); return fmaxf(a, b); }
__device__ __forceinline__ float xrow16_sum(float x) { float a, b; px_swap16(x, x, a, b); x = a + b; px_swap32(x, x, a, b); return a + b; }
__device__ __forceinline__ void decode_unit(const Frame& F, int u) {
    constexpr int XOR1 = 0xB1, XOR2 = 0x4E, XOR7 = 0x141, XOR8 = 0x128, ROR4 = 0x124;
    const int sp = u % NSD, h = (u / NSD) & 7, b = u / (NSD * 8);
    LAS float* lds = (LAS float*)(F.lds + RING_OFF);
    int lane_ = F.lane; PX_OPAQUE_V(lane_);
    const int lane = lane_, wave = F.wave, r = lane >> 4, c = lane & 15;
    const float sl2 = exp2f(-(float)(h + 1)) * 1.4426950408889634f;
    const float* ck = F.fin(I_CK); const float* cv = F.fin(I_CV); const int* pt = (const int*)F.in[I_PT];
    const bf16* Qb = (const bf16*)(F.ws + WS_Q);
    const int p0 = sp * DEC_PPS;
    int btv = 0;
    if (lane < DEC_PPW) { const int lp = p0 + wave + 8 * lane; btv = pt[b * NPAGE + (lp >> 3)] * 8 + (lp & 7); }
    const int mc = c >> 3;
    u32x4 qpk[4];
#pragma unroll
    for (int t = 0; t < 4; ++t) qpk[t] = *(const u32x4*)(Qb + (size_t)(SMP0 + 4 * b + t) * 1024 + (2 * h + mc) * 64 + 8 * (c & 7));
    const unsigned loffb = (unsigned)(r * 1024 + 8 * c) * 4u;
#define DEC_ISSUE(i_) do { const int phys_ = px_readlane(btv, (i_)); const float* kb_ = ck + (size_t)phys_ * (16 * 1024) + h * 128; const float* vb_ = cv + (size_t)phys_ * (16 * 1024) + h * 128; \
    _Pragma("unroll") for (int t_ = 0; t_ < 4; ++t_) { const unsigned o_ = loffb + (unsigned)t_ * 16384u; \
        Kn[t_][0] = px_bufload16(kb_, o_); Kn[t_][1] = px_bufload16(kb_, o_ + 16u); Vn[t_][0] = px_bufload16(vb_, o_); Vn[t_][1] = px_bufload16(vb_, o_ + 16u); } } while (0)
    u32x4 Kn[4][2], Vn[4][2];
    float m[2], l[2], acc[64];
#pragma unroll
    for (int j = 0; j < 2; ++j) { m[j] = -INFINITY; l[j] = 0.f; }
#pragma unroll
    for (int k = 0; k < 64; ++k) acc[k] = 0.f;
    DEC_ISSUE(0);
    for (int i = 0; i < DEC_PPW; ++i) {
        u32x4 Kc[4], Vc[4];
#pragma unroll
        for (int t = 0; t < 4; ++t) { Kc[t] = tobf8(Kn[t][0], Kn[t][1]); Vc[t] = tobf8(Vn[t][0], Vn[t][1]); }
        const int lp = p0 + wave + 8 * i;
        if (i + 1 < DEC_PPW) DEC_ISSUE(i + 1);
        float x[32];
#pragma unroll
        for (int t = 0; t < 4; ++t)
#pragma unroll
            for (int tq = 0; tq < 4; ++tq) { float d = 0.f;
#pragma unroll
                for (int k = 0; k < 4; ++k) d = px_dot2(Kc[t][k], qpk[tq][k], d);
                x[t * 8 + 2 * tq] = mc ? 0.f : d; x[t * 8 + 2 * tq + 1] = mc ? d : 0.f; }
#define TR_STEP(HALF, CTRL, BIT) _Pragma("unroll") for (int hx = 0; hx < (HALF); ++hx) _Pragma("unroll") for (int j = 0; j < 2; ++j) { \
      const float lo_ = x[hx * 2 + j], hi_ = x[(hx + (HALF)) * 2 + j]; const float t1_ = lo_ + px_dpp<CTRL>(lo_), t2_ = hi_ + px_dpp<CTRL>(hi_); \
      x[hx * 2 + j] = (c & (BIT)) ? t2_ : t1_; }
        TR_STEP(8, XOR8, 8) TR_STEP(4, XOR7, 4) TR_STEP(2, XOR2, 2) TR_STEP(1, XOR1, 1)
#undef TR_STEP
        const float bias = sl2 * (float)(lp * 16 + r + 4 * (c >> 2) - PASTLEN);
        float p[2], alpha[2];
#pragma unroll
        for (int j = 0; j < 2; ++j) {
            const float sc = x[j] + bias;
            float pm = sc; pm = fmaxf(pm, px_dpp<ROR4>(pm)); pm = fmaxf(pm, px_dpp<XOR8>(pm)); pm = xrow16_max(pm);
            const float mn = fmaxf(m[j], pm);
            alpha[j] = px_exp2(m[j] - mn); p[j] = px_exp2(sc - mn);
            l[j] = fmaf(l[j], alpha[j], p[j]); m[j] = mn;
        }
#pragma unroll
        for (int q4 = 0; q4 < 4; ++q4)
#pragma unroll
            for (int j = 0; j < 2; ++j) {
                const float al = q4 == 0 ? px_dpp<0x00>(alpha[j]) : q4 == 1 ? px_dpp<0x55>(alpha[j]) : q4 == 2 ? px_dpp<0xAA>(alpha[j]) : px_dpp<0xFF>(alpha[j]);
#pragma unroll
                for (int k = 0; k < 8; ++k) acc[(q4 * 2 + j) * 8 + k] *= al; }
        LAS float* prow = lds + DLDS_P + (wave * 4 + r) * 32;
#pragma unroll
        for (int j = 0; j < 2; ++j) prow[c * 2 + j] = p[j];
        px_wave_sync();
#pragma unroll
        for (int t = 0; t < 4; ++t) {
            const f32x4 pa = *(const LAS f32x4*)(prow + 8 * t), pb = *(const LAS f32x4*)(prow + 8 * t + 4);
            float vf[8];
#pragma unroll
            for (int k = 0; k < 4; ++k) { vf[2 * k] = bf_lo(Vc[t][k]); vf[2 * k + 1] = bf_hi(Vc[t][k]); }
#pragma unroll
            for (int g = 0; g < 8; ++g) { const float pg_ = g < 4 ? pa[g & 3] : pb[g & 3];
#pragma unroll
                for (int k = 0; k < 8; ++k) acc[g * 8 + k] = fmaf(pg_, vf[k], acc[g * 8 + k]); }
            asm volatile("" ::: "memory"); }
        px_wave_sync();
    }
#undef DEC_ISSUE
    int lane2 = lane; PX_OPAQUE_V(lane2);
    const int r2 = lane2 >> 4, c2 = lane2 & 15;
#pragma unroll
    for (int k = 0; k < 64; ++k) acc[k] = xrow16_sum(acc[k]);
#pragma unroll
    for (int j = 0; j < 2; ++j) { float t = l[j]; t += px_dpp<ROR4>(t); t += px_dpp<XOR8>(t); l[j] = xrow16_sum(t); }
    LAS float* mrg = lds + DLDS_MRG;
    if (r2 == 0) {
#pragma unroll
        for (int g = 0; g < 8; ++g) { LAS float* rec = mrg + (wave * 8 + g) * DMRG_REC;
#pragma unroll
            for (int k = 0; k < 8; k += 4) *(LAS f32x4*)(rec + 4 + 8 * c2 + k) = (f32x4){acc[g * 8 + k], acc[g * 8 + k + 1], acc[g * 8 + k + 2], acc[g * 8 + k + 3]};
            if (c2 == g / 2) { rec[0] = m[g % 2]; rec[1] = l[g % 2]; } } }
    px_block_sync();
    {
        const int g = wave, d0 = 2 * lane2;
        float M = -INFINITY;
#pragma unroll
        for (int w = 0; w < 8; ++w) M = fmaxf(M, mrg[(w * 8 + g) * DMRG_REC]);
        float L = 0.f, o0 = 0.f, o1 = 0.f;
#pragma unroll
        for (int w = 0; w < 8; ++w) { const LAS float* rec = mrg + (w * 8 + g) * DMRG_REC; const float lw = rec[1]; const float wt = px_exp2(rec[0] - M);
            L = fmaf(wt, lw, L); o0 = fmaf(wt, rec[4 + d0], o0); o1 = fmaf(wt, rec[4 + d0 + 1], o1); }
        float* dst = (float*)(F.ws + WS_DEC) + ((size_t)(((b * 8 + h) * NSD + sp) * 8 + g)) * DEC_REC;
        *(f32x2*)(dst + 4 + d0) = (f32x2){o0, o1};
        if (lane2 == 0) *(f32x2*)dst = (f32x2){M, L};
    }
    px_block_sync();
}
__device__ __forceinline__ void decode_combine(const Frame& F, int bh) {
    const int b = bh >> 3, h = bh & 7, lane = F.lane, d0 = 2 * lane, g = F.wave, t = g >> 1, m = g & 1;
    const float lam = ((const float*)(F.ws + WS_PAR + PAR_LAM))[0], sl2 = exp2f(-(float)(h + 1)) * 1.4426950408889634f;
    const bf16* Qb = (const bf16*)(F.ws + WS_Q); const float* KS = F.out + OFF_KS; const float* VS = F.out + OFF_VS; bf16* OC = (bf16*)(F.ws + WS_OC);
    LAS float* cmb = (LAS float*)(F.lds + RING_OFF);
    {
        const float* rec0 = (const float*)(F.ws + WS_DEC) + ((size_t)(((b * 8 + h) * NSD) * 8 + g)) * DEC_REC;
        float M = -INFINITY;
        for (int s = 0; s < NSD; ++s) M = fmaxf(M, rec0[(size_t)s * 8 * DEC_REC]);
        float sn[4];
        const float qv = bf2f(Qb[(size_t)(SMP0 + 4 * b + t) * 1024 + (2 * h + m) * 64 + lane]);
#pragma unroll
        for (int tp = 0; tp < 4; ++tp) { const float sc = wave_sum(qv * KS[(size_t)(4 * b + tp) * 1024 + (2 * h + m) * 64 + lane]) + sl2 * (float)tp; sn[tp] = (tp <= t) ? sc : -INFINITY; M = fmaxf(M, sn[tp]); }
        float L = 0.f, o0 = 0.f, o1 = 0.f;
        for (int s = 0; s < NSD; ++s) { const float* rec = rec0 + (size_t)s * 8 * DEC_REC; const float w = px_exp2(rec[0] - M); L = fmaf(w, rec[1], L); o0 = fmaf(w, rec[4 + d0], o0); o1 = fmaf(w, rec[4 + d0 + 1], o1); }
#pragma unroll
        for (int tp = 0; tp < 4; ++tp) { const float w = px_exp2(sn[tp] - M); const f32x2 vv = *(const f32x2*)(VS + (size_t)(4 * b + tp) * 1024 + h * 128 + d0); L += w; o0 = fmaf(w, vv[0], o0); o1 = fmaf(w, vv[1], o1); }
        const float il = 1.0f / L; *(LAS f32x2*)(cmb + g * 128 + d0) = (f32x2){o0 * il, o1 * il};
    }
    px_block_sync();
    if (F.wave < 4) { const int tt = F.wave; const f32x2 a = *(const LAS f32x2*)(cmb + (2 * tt) * 128 + d0), bq = *(const LAS f32x2*)(cmb + (2 * tt + 1) * 128 + d0);
        const f32x2 sg = *(const f32x2*)(F.fin(I_SUBG) + d0);
        const float c0 = a[0] - lam * bq[0], c1 = a[1] - lam * bq[1];
        const float rstd = px_rsq(wave_sum(c0 * c0 + c1 * c1) * (1.0f / 128.f) + EPSN) * 0.8f;
        *(unsigned*)(OC + (size_t)(SMP0 + 4 * b + tt) * DM + h * 128 + d0) = pk2(c0 * rstd * sg[0], c1 * rstd * sg[1]); }
    px_block_sync();
}
template <class Epi>
__device__ __forceinline__ void skinny_unit(const Frame& F, const bf16* Ae, const bf16* Bt, int K, int n0, const Epi& E) {
    const int lane = F.lane, l15 = lane & 15, l4 = lane >> 4, wave = F.wave;
    const int kw = K >> 3, kbeg = wave * kw, nst = kw >> 5;
    f32x4 acc[4];
#pragma unroll
    for (int nb = 0; nb < 4; ++nb) acc[nb] = (f32x4){0.f, 0.f, 0.f, 0.f};
    const bf16* w0 = Bt + (size_t)(n0 + l15) * K + kbeg + 8 * l4;
    const bf16* a0 = Ae + (size_t)l15 * K + kbeg + 8 * l4;
    for (int s0 = 0; s0 < nst; s0 += 4) {
        bf16x8 wf[4], af[4][4];
#pragma unroll
        for (int q = 0; q < 4; ++q) { const int ks = (s0 + q < nst ? s0 + q : nst - 1) * 32; wf[q] = *(const bf16x8*)(w0 + ks);
#pragma unroll
            for (int nb = 0; nb < 4; ++nb) af[q][nb] = *(const bf16x8*)(a0 + (size_t)nb * 16 * K + ks); }
#pragma unroll
        for (int q = 0; q < 4; ++q) if (s0 + q < nst) {
#pragma unroll
            for (int nb = 0; nb < 4; ++nb) acc[nb] = px_mfma16(wf[q], af[q][nb], acc[nb]); }
    }
    LAS float* red = (LAS float*)(F.lds + RING_OFF);
#pragma unroll
    for (int nb = 0; nb < 4; ++nb)
#pragma unroll
        for (int r = 0; r < 4; ++r) red[(wave * 16 + 4 * l4 + r) * 64 + nb * 16 + l15] = acc[nb][r];
    px_block_sync();
#pragma unroll
    for (int j = 0; j < 2; ++j) { const int idx = F.tid + NTHR * j, m = idx >> 6, er = idx & 63; float v0 = 0.f;
#pragma unroll
        for (int w = 0; w < 8; ++w) v0 += red[(w * 16 + m) * 64 + er];
        if (er < NMETA + NSMP) E(er, n0 + m, v0); }
    px_block_sync();
}
struct SkEpiF32 { float* M;
    __device__ __forceinline__ void operator()(int er, int c, float v) const { M[(size_t)(META0 + er) * DM + c] = v; } };
struct SkEpiU { const float* rs; bf16* U;
    __device__ __forceinline__ void operator()(int er, int c, float v) const { const int row = META0 + er; U[(size_t)row * DM + c] = (bf16)f2bf(v * rs[row]); } };
struct SkEpiGlu { const bf16* Y; bf16* Y2;
    __device__ __forceinline__ void operator()(int er, int c, float v) const { const size_t o = (size_t)(META0 + er) * DM + c; Y2[o] = (bf16)f2bf(bf2f(Y[o]) * sigmoidf_(v)); } };
template <class Epi>
__device__ __forceinline__ void skinny_phase(const Frame& F, const bf16* A, const bf16* Bt, int N, int K, const Epi& E, int emu_base) {
    const int nbu = N / 16;
    for (int bu = (int)gridDim.x - 1 - (int)blockIdx.x; bu < nbu; bu += (int)gridDim.x) { if (!EMU_UNIT_OK(emu_base + bu)) continue;
        skinny_unit(F, A + (size_t)META0 * K, Bt, K, 16 * bu, E); }
}

#ifndef MK_N_LAUNCHES
#define MK_N_LAUNCHES 1
#endif
constexpr int N_PHASES = 18, N_LAUNCHES = MK_N_LAUNCHES;
#ifndef HOST_EMU
__device__ __forceinline__ void attn_main_units(const Frame& F, char* ldsc, int ja, int na) {
    const attn_body::bf16* Q = (const attn_body::bf16*)(F.ws + WS_Q); const attn_body::bf16* K = (const attn_body::bf16*)(F.ws + WS_KB);
    const attn_body::bf16* V = (const attn_body::bf16*)(F.ws + WS_VB); attn_body::bf16* O = (attn_body::bf16*)(F.ws + WS_O2);
    for (int vi = 4 * ja; vi < 1024; vi = ((vi & 3) == 3) ? vi - 3 + 4 * na : vi + 1) {
        const int v = vi >> 2, i = vi & 3, combo = v >> 1, dh = combo & 1, hm = (combo >> 1) & 15, b = combo >> 5, ps = v & 1;
        const int qb = ps == 0 ? (i == 0 ? 0 : i == 1 ? 7 : i == 2 ? 1 : 6) : (i == 0 ? 2 : i == 1 ? 5 : i == 2 ? 3 : 4);
        const int h = hm >> 1;
        const float sl2 = __builtin_bit_cast(float, __builtin_amdgcn_readfirstlane(__builtin_bit_cast(int, exp2f(-(float)(h + 1)) * 1.4426950408889634f)));
        attn_body::attn_unit<8>(b * SEQ + qb * 256, b * KROWS, qb, hm * 64, (2 * h + dh) * 64, hm * 128 + dh * 64, sl2, Q, K, V, O, ldsc);
    }
}
#endif

__device__ __forceinline__ int px_opq(int x) { PX_OPAQUE_S(x); return x; }
__global__ void __launch_bounds__(NTHR, 2) mega_fwd(Args args) {
    PX_DYN_LDS(lds);
    Frame F;
    F.lds = (LAS unsigned char*)lds;
    F.tid = threadIdx.x; F.lane = F.tid & 63; F.wave = px_rfl(F.tid >> 6);
    F.G = gridDim.x; { const int bx = blockIdx.x; F.vcu = (F.G % 8 == 0) ? (bx % 8) * (F.G / 8) + bx / 8 : bx; }
    F.in = args.in; F.out = args.out; F.ws = args.ws;
    const int lo = args.ph_lo, hi = args.ph_hi;
#ifndef HOST_EMU
    volatile LAS unsigned* MISC = (volatile LAS unsigned*)(F.lds + MISC_OFF);
    for (int u = F.tid; u < (LDS_BYTES - LDSCTL_OFF) / 4; u += NTHR) ((LAS unsigned*)(F.lds + LDSCTL_OFF))[u] = 0u;
    __syncthreads();
    XcdBarrier bar; bar.bar = (unsigned*)(F.ws + WS_CTL) + CW_BAR; bar.x = 0; bar.st = nullptr;
    if (N_LAUNCHES == 1) bar = xcd_barrier_post((unsigned*)(F.ws + WS_CTL) + CW_BAR, MISC + 8);
#define GRID_BAR() do { if (N_LAUNCHES == 1) xcd_barrier(bar); } while (0)
#else
#define GRID_BAR() do { } while (0)
#endif
#ifdef PH_MASK
#define IN(k) ((((PH_MASK) >> (k)) & 1) && lo <= (k) && (k) < hi)
#else
#define IN(k) (lo <= (k) && (k) < hi)
#endif
#define SEAM(k) do { if (IN(k) && IN((k) + 1)) GRID_BAR(); } while (0)
#ifndef REP_MASK
#define REP_MASK 0
#endif
#define REPS(k) (1 + (((REP_MASK) >> (k)) & 1))
#define FRESH() do { F.lane = px_lane_id(); F.tid = F.wave * 64 + F.lane; } while (0)
    const float* RS = (const float*)(F.ws + WS_RS);
    bf16* XB = (bf16*)(F.ws + WS_XB); float* MB = (float*)(F.ws + WS_M); bf16* HID = (bf16*)(F.ws + WS_HID); bf16* OC = (bf16*)(F.ws + WS_OC);

    constexpr int IT_IN1 = WI_IN0 + WI_SQ, IT_GU0 = WI_IN0 + 4 * WI_SQ, IT_GU1 = IT_GU0 + WI_GU, IT_D0 = IT_GU0 + 2 * WI_GU, IT_D1 = IT_D0 + WI_D;
#define WITEMS(first, n, wv, nwv, ebase) do { LAS float* scr_ = (LAS float*)(F.lds + RING_OFF + F.wave * 16384); \
        for (int j_ = (wv); j_ < (n); j_ += (nwv)) if (EMU_UNIT_OK((ebase) + j_)) p0_weight_item(F, (first) + j_, scr_); } while (0)
#define IDLE_DEAL(nwg) const int rem_ = (nwg) % F.G, nidle_ = rem_ ? F.G - rem_ : F.G, ci_ = (int)blockIdx.x - (rem_ ? rem_ : 0); const bool idle_ = ci_ >= 0; const int wv_ = ci_ * NWAVES + F.wave, nwv_ = nidle_ * NWAVES

    if (IN(0)) _Pragma("nounroll") for (int rep_ = 0, nrep_ = (REPS(0) > 1 ? px_opq(REPS(0)) : 1); rep_ < nrep_; ++rep_) { FRESH();
        const int gw = F.vcu * NWAVES + F.wave, NGW = F.G * NWAVES;
        WITEMS(0, WI_IN0 + WI_SQ, gw, NGW, 0); WITEMS(IT_GU0, WI_GU, gw, NGW, IT_GU0); WITEMS(IT_D0, WI_D, gw, NGW, IT_D0);
        p0_prologue(F); if (rep_ + 1 < nrep_) GRID_BAR(); } SEAM(0);
    if (IN(1)) _Pragma("nounroll") for (int rep_ = 0, nrep_ = (REPS(1) > 1 ? px_opq(REPS(1)) : 1); rep_ < nrep_; ++rep_) { FRESH();
        pg8::Gemm g{XB, (const bf16*)(F.ws + WS_WIN0), MP, NIN0, DM}; pg8::StaticOrder S; S.init(MP, NIN0, F.G, (int)blockIdx.x);
        pg8::EpiIn0 E{RS, (bf16*)(F.ws + WS_Q), (bf16*)(F.ws + WS_KB), (bf16*)(F.ws + WS_VB), (bf16*)(F.ws + WS_G), F.out};
        pg8::gemm_phase<pg8::EpiIn0, pg8::StaticOrder, true, true>(F.lds + RING_OFF, g, S, E);
        FRESH();
        { IDLE_DEAL((MP / 256) * (NIN0 / 256)); if (idle_) { WITEMS(IT_IN1, 3 * WI_SQ, wv_, nwv_, 200000 + IT_IN1); WITEMS(IT_GU1, WI_GU, wv_, nwv_, 200000 + IT_GU1); } } if (rep_ + 1 < nrep_) GRID_BAR(); } SEAM(1);
    if (IN(2)) _Pragma("nounroll") for (int rep_ = 0, nrep_ = (REPS(2) > 1 ? px_opq(REPS(2)) : 1); rep_ < nrep_; ++rep_) { FRESH();
#ifndef PH2_MASK
#define PH2_MASK 15
#endif
        const bool split = (F.G % 2 == 0);
        if (PH2_MASK & 4) for (int u = F.vcu; u < CONV_UNITS; u += F.G) if (EMU_UNIT_OK(1000 + u)) conv_phase_unit(F, u);
        FRESH();
        if (PH2_MASK & 8) if (F.vcu == 255 % F.G && EMU_UNIT_OK(2000)) meta_attn(F);
#ifndef HOST_EMU
        if ((PH2_MASK & 1) && (!split || (F.vcu & 1) == 0)) attn_main_units(F, (char*)lds + RING_OFF, split ? (F.vcu >> 1) : F.vcu, split ? (F.G >> 1) : F.G);
#endif
        FRESH();
        if ((PH2_MASK & 2) && (!split || (F.vcu & 1) == 1)) for (int u = split ? (F.vcu >> 1) : F.vcu; u < DEC_UNITS; u += split ? (F.G >> 1) : F.G) if (EMU_UNIT_OK(u)) decode_unit(F, u);
    if (rep_ + 1 < nrep_) GRID_BAR(); } SEAM(2);
    if (IN(3)) _Pragma("nounroll") for (int rep_ = 0, nrep_ = (REPS(3) > 1 ? px_opq(REPS(3)) : 1); rep_ < nrep_; ++rep_) { FRESH();
        const int gw = F.vcu * NWAVES + F.wave, NGW = F.G * NWAVES;
        for (int row = gw; row < MAIN; row += NGW) if (EMU_UNIT_OK(row)) combine_row(F, row);
        for (int bh = F.vcu; bh < 64; bh += F.G) if (EMU_UNIT_OK(10000 + bh)) decode_combine(F, bh);
    if (rep_ + 1 < nrep_) GRID_BAR(); } SEAM(3);
    if (IN(4)) _Pragma("nounroll") for (int rep_ = 0, nrep_ = (REPS(4) > 1 ? px_opq(REPS(4)) : 1); rep_ < nrep_; ++rep_) { FRESH();
        pg8::Gemm g{OC, (const bf16*)(F.ws + WS_WOUT0), MAIN, DM, DM}; pg8::StaticOrder S; S.init(MAIN, DM, F.G, (int)blockIdx.x);
        pg8::EpiF32 E{MB, DM}; pg8::gemm_phase<pg8::EpiF32, pg8::StaticOrder, true, true>(F.lds + RING_OFF, g, S, E);
        FRESH(); SkEpiF32 SE{MB}; skinny_phase(F, OC, (const bf16*)(F.ws + WS_WOUT0), DM, DM, SE, 100000); if (rep_ + 1 < nrep_) GRID_BAR(); } SEAM(4);
    if (IN(5)) { FRESH(); resid_phase(F, F.fin(I_NMPOST), true, false); } SEAM(5);
    if (IN(6)) _Pragma("nounroll") for (int rep_ = 0, nrep_ = (REPS(6) > 1 ? px_opq(REPS(6)) : 1); rep_ < nrep_; ++rep_) { FRESH();
        pg8::Gemm g{XB, (const bf16*)(F.ws + WS_WGU0), MP, NGU, DM}; pg8::StaticOrder S; S.init(MP, NGU, F.G, (int)blockIdx.x);
        pg8::EpiGU E{RS, HID}; pg8::gemm_phase<pg8::EpiGU, pg8::StaticOrder, true, true>(F.lds + RING_OFF, g, S, E);
        FRESH();
        { IDLE_DEAL((MP / 256) * (NGU / 256)); if (idle_) { WITEMS(IT_D1, WI_D, wv_, nwv_, 200000 + IT_D1); } } if (rep_ + 1 < nrep_) GRID_BAR(); } SEAM(6);
    if (IN(7)) _Pragma("nounroll") for (int rep_ = 0, nrep_ = (REPS(7) > 1 ? px_opq(REPS(7)) : 1); rep_ < nrep_; ++rep_) { FRESH();
        pg8::Gemm g{HID, (const bf16*)(F.ws + WS_WD0), MAIN, DM, DFF}; pg8::StaticOrder S; S.init(MAIN, DM, F.G, (int)blockIdx.x);
        pg8::EpiF32 E{MB, DM}; pg8::gemm_phase<pg8::EpiF32, pg8::StaticOrder, true, true>(F.lds + RING_OFF, g, S, E);
        FRESH(); SkEpiF32 SE{MB}; skinny_phase(F, HID, (const bf16*)(F.ws + WS_WD0), DM, DFF, SE, 100000); if (rep_ + 1 < nrep_) GRID_BAR(); } SEAM(7);
    if (IN(8)) { FRESH(); resid_phase(F, F.fin(I_NFPOST), false, false); } SEAM(8);
    if (IN(9)) _Pragma("nounroll") for (int rep_ = 0, nrep_ = (REPS(9) > 1 ? px_opq(REPS(9)) : 1); rep_ < nrep_; ++rep_) { FRESH();
        pg8::Gemm g{XB, (const bf16*)(F.ws + WS_WIN1), MAIN, DM, DM}; pg8::StaticOrder S; S.init(MAIN, DM, F.G, (int)blockIdx.x);
        pg8::EpiU E{RS, (bf16*)(F.ws + WS_U)}; pg8::gemm_phase<pg8::EpiU, pg8::StaticOrder, true, true>(F.lds + RING_OFF, g, S, E);
        FRESH(); SkEpiU SE{RS, (bf16*)(F.ws + WS_U)}; skinny_phase(F, XB, (const bf16*)(F.ws + WS_WIN1), DM, DM, SE, 100000); if (rep_ + 1 < nrep_) GRID_BAR(); } SEAM(9);
    if (IN(10)) _Pragma("nounroll") for (int rep_ = 0, nrep_ = (REPS(10) > 1 ? px_opq(REPS(10)) : 1); rep_ < nrep_; ++rep_) { FRESH(); for (int u = F.vcu; u < S1_UNITS; u += F.G) if (EMU_UNIT_OK(u)) ssm_pass1_unit(F, u); if (rep_ + 1 < nrep_) GRID_BAR(); } SEAM(10);
    if (IN(11)) _Pragma("nounroll") for (int rep_ = 0, nrep_ = (REPS(11) > 1 ? px_opq(REPS(11)) : 1); rep_ < nrep_; ++rep_) { FRESH(); for (int u = F.vcu; u < S2_UNITS; u += F.G) if (EMU_UNIT_OK(u)) ssm_pass2_unit(F, u); if (rep_ + 1 < nrep_) GRID_BAR(); } SEAM(11);
    if (IN(12)) _Pragma("nounroll") for (int rep_ = 0, nrep_ = (REPS(12) > 1 ? px_opq(REPS(12)) : 1); rep_ < nrep_; ++rep_) { FRESH();
        pg8::Gemm g{(const bf16*)(F.ws + WS_Y), (const bf16*)(F.ws + WS_WGLU), MAIN, DM, DM}; pg8::StaticOrder S; S.init(MAIN, DM, F.G, (int)blockIdx.x);
        pg8::EpiGlu E{(const bf16*)(F.ws + WS_Y), (bf16*)(F.ws + WS_Y2)}; pg8::gemm_phase<pg8::EpiGlu, pg8::StaticOrder, true, true>(F.lds + RING_OFF, g, S, E);
        FRESH(); SkEpiGlu SE{(const bf16*)(F.ws + WS_Y), (bf16*)(F.ws + WS_Y2)}; skinny_phase(F, (const bf16*)(F.ws + WS_Y), (const bf16*)(F.ws + WS_WGLU), DM, DM, SE, 100000); if (rep_ + 1 < nrep_) GRID_BAR(); } SEAM(12);
    if (IN(13)) _Pragma("nounroll") for (int rep_ = 0, nrep_ = (REPS(13) > 1 ? px_opq(REPS(13)) : 1); rep_ < nrep_; ++rep_) { FRESH();
        pg8::Gemm g{(const bf16*)(F.ws + WS_Y2), (const bf16*)(F.ws + WS_WOUT1), MAIN, DM, DM}; pg8::StaticOrder S; S.init(MAIN, DM, F.G, (int)blockIdx.x);
        pg8::EpiF32 E{MB, DM}; pg8::gemm_phase<pg8::EpiF32, pg8::StaticOrder, true, true>(F.lds + RING_OFF, g, S, E);
        FRESH(); SkEpiF32 SE{MB}; skinny_phase(F, (const bf16*)(F.ws + WS_Y2), (const bf16*)(F.ws + WS_WOUT1), DM, DM, SE, 100000); if (rep_ + 1 < nrep_) GRID_BAR(); } SEAM(13);
    if (IN(14)) { FRESH(); resid_phase(F, F.fin(I_NMPOST) + DM, false, false); } SEAM(14);
    if (IN(15)) _Pragma("nounroll") for (int rep_ = 0, nrep_ = (REPS(15) > 1 ? px_opq(REPS(15)) : 1); rep_ < nrep_; ++rep_) { FRESH();
        pg8::Gemm g{XB, (const bf16*)(F.ws + WS_WGU1), MP, NGU, DM}; pg8::StaticOrder S; S.init(MP, NGU, F.G, (int)blockIdx.x);
        pg8::EpiGU E{RS, HID}; pg8::gemm_phase<pg8::EpiGU, pg8::StaticOrder, true, true>(F.lds + RING_OFF, g, S, E);
 if (rep_ + 1 < nrep_) GRID_BAR(); } SEAM(15);
    if (IN(16)) _Pragma("nounroll") for (int rep_ = 0, nrep_ = (REPS(16) > 1 ? px_opq(REPS(16)) : 1); rep_ < nrep_; ++rep_) { FRESH();
        pg8::Gemm g{HID, (const bf16*)(F.ws + WS_WD1), MAIN, DM, DFF}; pg8::StaticOrder S; S.init(MAIN, DM, F.G, (int)blockIdx.x);
        pg8::EpiF32 E{MB, DM}; pg8::gemm_phase<pg8::EpiF32, pg8::StaticOrder, true, true>(F.lds + RING_OFF, g, S, E);
        FRESH(); SkEpiF32 SE{MB}; skinny_phase(F, HID, (const bf16*)(F.ws + WS_WD1), DM, DFF, SE, 100000); if (rep_ + 1 < nrep_) GRID_BAR(); } SEAM(16);
    if (IN(17)) { FRESH(); resid_phase(F, F.fin(I_NFPOST) + DM, false, true); }
#undef WITEMS
#undef IDLE_DEAL
#undef IN
#undef SEAM
#undef FRESH
#undef GRID_BAR
}

#ifndef HOST_EMU
extern "C" void kernel_launch(void* const* d_in, const int* in_sizes, int n_in, void* d_out, int out_size, void* d_ws, size_t ws_size, hipStream_t stream) {
    static int grid = 0;
    if (grid == 0) {
        if (n_in != N_IN || (size_t)out_size != OUT_TOTAL || ws_size < WS_END) { fprintf(stderr, "kernel_launch: unexpected problem (n_in %d, out %d, ws %zu)\n", n_in, out_size, ws_size); grid = -1; return; }
        int dev = 0, cus = 0, per_cu = 0;
        if (hipGetDevice(&dev) != hipSuccess || hipDeviceGetAttribute(&cus, hipDeviceAttributeMultiprocessorCount, dev) != hipSuccess) { grid = -1; return; }
        if (hipFuncSetAttribute((const void*)mega_fwd, hipFuncAttributeMaxDynamicSharedMemorySize, LDS_BYTES) != hipSuccess) { fprintf(stderr, "kernel_launch: hipFuncSetAttribute failed\n"); grid = -1; return; }
        if (hipOccupancyMaxActiveBlocksPerMultiprocessor(&per_cu, (const void*)mega_fwd, NTHR, LDS_BYTES) != hipSuccess || per_cu < 1) { fprintf(stderr, "kernel_launch: occupancy query says %d\n", per_cu); }
        (void)hipGetLastError();
        grid = cus;
    }
    if (grid < 0) return;
    if (hipMemsetAsync((char*)d_ws + WS_CTL, 0, CTL_ZERO_BYTES, stream) != hipSuccess) return;
    Args a{};
    for (int i = 0; i < N_IN; ++i) a.in[i] = d_in[i];
    a.out = (float*)d_out; a.ws = (unsigned char*)d_ws;
    for (int li = 0; li < N_LAUNCHES; ++li) {
        a.ph_lo = (N_LAUNCHES == 1) ? 0 : li; a.ph_hi = (N_LAUNCHES == 1) ? N_PHASES : li + 1;
        hipLaunchKernelGGL(mega_fwd, dim3(grid), dim3(NTHR), LDS_BYTES, stream, a);
        const hipError_t le = hipPeekAtLastError();
        if (le != hipSuccess) { fprintf(stderr, "kernel_launch: launch %d failed: %s\n", li, hipGetErrorName(le)); break; }
    }
}
#endif
```
